# Optimizing an MI355X kernel written in HIP

```python
import jax, jax.numpy as jnp
from jax import lax
import numpy as np

D_MODEL = 2048
BATCH = 2
SEQ = 8192
DEPTH = 4

CHUNK = 64
N_MIXERS = 2
POOL_WINDOWS = (2, 4, 8, 16)
N_POOL_GROUPS = len(POOL_WINDOWS)
POOL_GROUP_DIM = D_MODEL // N_POOL_GROUPS
HGRN_EXPAND = 128
HGRN_HEADS = D_MODEL // HGRN_EXPAND
HGRN_DK = HGRN_EXPAND
HGRN_DV = D_MODEL // HGRN_HEADS
D_FF = -(-8 * D_MODEL // (3 * 256)) * 256
N_MOD = 6
EPS = 1e-6

kernel_name = 'hybrid_pool_hgrn2_adaln_trunk'


def rms_norm(x, gain):
    xf = x.astype(jnp.float32)
    y = xf * lax.rsqrt(jnp.mean(xf * xf, axis=-1, keepdims=True) + EPS)
    return (y * gain.astype(jnp.float32)).astype(x.dtype)


def pool_mixer(h, w_group, chan_scale):
    B, S, D = h.shape
    hg = h.astype(jnp.float32).reshape(B, S, N_POOL_GROUPS, POOL_GROUP_DIM)
    cs = jnp.cumsum(hg, axis=1)
    pos = jnp.arange(1, S + 1, dtype=jnp.float32)
    outs = []
    for g, w in enumerate(POOL_WINDOWS):
        csg = cs[:, :, g]
        lo = jnp.concatenate([jnp.zeros((B, w, POOL_GROUP_DIM), jnp.float32), csg[:, :S - w]], axis=1)
        mean = (csg - lo) / jnp.minimum(pos, float(w))[None, :, None]
        outs.append(mean - hg[:, :, g])
    d = jnp.stack(outs, axis=2).astype(h.dtype)
    y = jnp.einsum('bsgc,gcd->bsgd', d, w_group).reshape(B, S, D)
    return y * chan_scale


def hgrn_lower_bounds(lb_params):
    p = jax.nn.softmax(lb_params.astype(jnp.float32), axis=0)
    return jnp.cumsum(p, axis=0) - p[0]


def hgrn2_mixer(h, w_in, w_out, out_norm_gain, lower_bound):
    B, S, D = h.shape
    nc = S // CHUNK
    proj = h @ w_in
    q, f_pre, v, g_out = jnp.split(proj, 4, axis=-1)
    f = lower_bound + (1.0 - lower_bound) * jax.nn.sigmoid(f_pre.astype(jnp.float32))
    log_f = jnp.log(f)
    k = 1.0 - f

    def to_chunks(t, dh):
        return t.astype(jnp.float32).reshape(B, nc, CHUNK, HGRN_HEADS, dh).transpose(1, 0, 3, 2, 4)

    qc = to_chunks(q, HGRN_DK)
    kc = to_chunks(k, HGRN_DK)
    vc = to_chunks(v, HGRN_DV)
    bc = jnp.cumsum(to_chunks(log_f, HGRN_DK), axis=3)
    mask = jnp.tril(jnp.ones((CHUNK, CHUNK), dtype=bool))

    def step(state, xs):
        q_c, k_c, v_c, b_c = xs
        diff = b_c[:, :, :, None, :] - b_c[:, :, None, :, :]
        decay = jnp.exp(jnp.where(mask[:, :, None], diff, -jnp.inf))
        scores = jnp.einsum('bhtd,bhsd,bhtsd->bhts', q_c, k_c, decay)
        o = (jnp.einsum('bhts,bhsv->bhtv', scores, v_c)
             + jnp.einsum('bhtd,bhdv->bhtv', q_c * jnp.exp(b_c), state))
        b_end = b_c[:, :, -1, :]
        state = (state * jnp.exp(b_end)[..., None]
                 + jnp.einsum('bhsd,bhsv->bhdv', k_c * jnp.exp(b_end[:, :, None, :] - b_c), v_c))
        return state, o

    state0 = jnp.zeros((B, HGRN_HEADS, HGRN_DK, HGRN_DV), jnp.float32)
    _, o = lax.scan(step, state0, (qc, kc, vc, bc))
    o = o.transpose(1, 0, 3, 2, 4).reshape(B, S, HGRN_HEADS, HGRN_DV)
    o = o * lax.rsqrt(jnp.mean(o * o, axis=-1, keepdims=True) + EPS)
    o = o.reshape(B, S, D) * out_norm_gain.astype(jnp.float32) * jax.nn.silu(g_out.astype(jnp.float32))
    return o.astype(h.dtype) @ w_out


def swiglu(h, w_in, w_out):
    a, b = jnp.split(h @ w_in, 2, axis=-1)
    return (jax.nn.silu(a) * b) @ w_out


def setup_inputs(seed: int = 0) -> dict:
    key = jax.random.key(seed)
    ks = jax.random.split(key, 16)
    n_pool = (DEPTH + 1) // 2
    n_hgrn = DEPTH // 2
    D, G = D_MODEL, POOL_GROUP_DIM
    nrm = jax.random.normal
    f32 = jnp.float32
    return {
        'x': nrm(ks[0], (BATCH, SEQ, D), f32),
        'c': nrm(ks[1], (BATCH, D), f32),
        'norm_mix_gain': 1.0 + 0.02 * nrm(ks[2], (DEPTH, D), f32),
        'norm_ffn_gain': 1.0 + 0.02 * nrm(ks[3], (DEPTH, D), f32),
        'w_ada': 0.5 * D ** -0.5 * nrm(ks[4], (DEPTH, D, N_MOD * D), f32),
        'b_ada': 0.02 * nrm(ks[5], (DEPTH, N_MOD * D), f32),
        'pool_w': G ** -0.5 * nrm(ks[6], (n_pool, N_POOL_GROUPS, G, G), f32),
        'pool_scale': 1.0 + 0.02 * nrm(ks[7], (n_pool, D), f32),
        'hgrn_w_in': D ** -0.5 * nrm(ks[8], (n_hgrn, D, 4 * D), f32),
        'hgrn_w_out': D ** -0.5 * nrm(ks[9], (n_hgrn, D, D), f32),
        'hgrn_norm_gain': 1.0 + 0.02 * nrm(ks[10], (n_hgrn, D), f32),
        'hgrn_lb': 1.0 + 0.1 * nrm(ks[11], (DEPTH, D), f32),
        'w_ffn_in': D ** -0.5 * nrm(ks[12], (DEPTH, D, 2 * D_FF), f32),
        'w_ffn_out': D_FF ** -0.5 * nrm(ks[13], (DEPTH, D_FF, D), f32),
        'final_gain': 1.0 + 0.02 * nrm(ks[14], (D,), f32),
    }


def reference(x, c, norm_mix_gain, norm_ffn_gain, w_ada, b_ada, pool_w, pool_scale,
              hgrn_w_in, hgrn_w_out, hgrn_norm_gain, hgrn_lb, w_ffn_in, w_ffn_out, final_gain):
    lower_bounds = hgrn_lower_bounds(hgrn_lb)
    cond = jax.nn.silu(c)
    for layer in range(DEPTH):
        mod = cond @ w_ada[layer] + b_ada[layer]
        sh_m, sc_m, g_m, sh_f, sc_f, g_f = jnp.split(mod[:, None, :], N_MOD, axis=-1)
        h = rms_norm(x, norm_mix_gain[layer]) * (1.0 + sc_m) + sh_m
        j = layer // N_MIXERS
        if layer % N_MIXERS == 0:
            y = pool_mixer(h, pool_w[j], pool_scale[j])
        else:
            y = hgrn2_mixer(h, hgrn_w_in[j], hgrn_w_out[j], hgrn_norm_gain[j],
                            lower_bounds[layer].astype(jnp.float32))
        x = x + g_m * y
        h = rms_norm(x, norm_ffn_gain[layer]) * (1.0 + sc_f) + sh_f
        x = x + g_f * swiglu(h, w_ffn_in[layer], w_ffn_out[layer])
    return rms_norm(x, final_gain)
```

```cpp
#include <hip/hip_runtime.h>
#include <cstdio>
#include <cstdint>
namespace pg8 {
#define PG8_LAS __attribute__((address_space(3)))
typedef unsigned short bf16_t;
typedef short bf16x8 __attribute__((ext_vector_type(8)));
typedef float f32x4 __attribute__((ext_vector_type(4)));
typedef unsigned u32x4 __attribute__((ext_vector_type(4)));
constexpr int BM = 256, BK = 64, HALF = 128, HTB = HALF * BK * 2  , STAGE_BYTES = 8 * HTB, NXCD = 8, WGM = 8;

__host__ __device__ __forceinline__ int lds_byte(int r, int c) { const int st = (r >> 4) * 2 + (c >> 5), rr = r & 15, cc = c & 31, ob = rr * 64 + cc * 2; return st * 1024 + (ob ^ (((ob >> 9) & 1) << 5)); }
__host__ __device__ __forceinline__ void stage_rc(int b, int& R, int& C) { const int st = b / 1024, sb = b % 1024, swz = sb ^ (((sb >> 9) & 1) << 5); R = (st >> 1) * 16 + swz / 64; C = (st & 1) * 32 + (swz % 64) / 2; }
__host__ __device__ __forceinline__ int perm32(int rho) { const int n = rho >> 4, i = rho & 15; return 8 * (i >> 2) + 4 * n + (i & 3); }

struct Unit { int pm, pn; };
struct Gemm { const bf16_t* A; const bf16_t* Bt; int lda, ldb, K, agrp_bytes; };

struct StaticOrder {
    int nM, nN, nwg, G, c;
    __host__ __device__ void init(int M, int N, int G_, int c_) { nM = M / BM; nN = N / BM; nwg = nM * nN; G = G_; c = c_; }
    __host__ __device__ bool next(int i, Unit& u) const {
        const long L = (long)i * G + c; if (L >= nwg) return false;
        int wgid = (int)L; { const int q = nwg / NXCD, r = nwg % NXCD, xcd = wgid % NXCD, off = wgid / NXCD; wgid = (xcd < r ? xcd * (q + 1) : r * (q + 1) + (xcd - r) * q) + off; }
        const int nig = WGM * nN, gid = wgid / nig, fm = gid * WGM, gsz = (nM - fm) < WGM ? (nM - fm) : WGM;
        u.pm = fm + ((wgid % nig) % gsz); u.pn = (wgid % nig) / gsz; return true;
    }
    __device__ __forceinline__ void a_ready(const Unit&) const {}
    __device__ __forceinline__ void done(const Unit&) const {}
};

__device__ __forceinline__ unsigned cvt_pk_bf16(float lo, float hi) { typedef float f2_ __attribute__((ext_vector_type(2))); typedef __bf16 b2_ __attribute__((ext_vector_type(2))); const f2_ v = {lo, hi}; return __builtin_bit_cast(unsigned, __builtin_convertvector(v, b2_)); }

template <class Epi, class Sched, bool ALIGN_EPI = false, bool SP2 = false, int XP = 0  >
__device__ __forceinline__ void gemm_phase(PG8_LAS unsigned char* lds, const Gemm g, const Sched& S, const Epi& E, const int wid) {
    const int lane = __builtin_amdgcn_mbcnt_hi(~0u, __builtin_amdgcn_mbcnt_lo(~0u, 0u)), tid = wid * 64 + lane, wr = wid >> 2, wc = wid & 3, fr = lane & 15, fq = lane >> 4;
    const int K = g.K, nt = K / BK;
    unsigned voffA[2], voffB[2];
#pragma unroll
    for (int i = 0; i < 2; ++i) { int R, C; stage_rc(tid * 16 + i * 8192, R, C); const int Rb = Epi::PERM ? ((R & ~31) + perm32(R & 31)) : R;
        voffA[i] = (unsigned)(R * g.lda + C) * 2u; voffB[i] = (unsigned)(Rb * g.ldb + C) * 2u; }
    const unsigned kstep = (unsigned)(BK * 2);
    const unsigned hstepA = (unsigned)HALF * g.lda * 2, hstepB = (unsigned)HALF * g.ldb * 2;
    const unsigned tstepA = 2 * hstepA, tstepB = 2 * hstepB;
    const __amdgpu_buffer_rsrc_t rsA = __builtin_amdgcn_make_buffer_rsrc((void*)g.A, (short)0, 0x7ffffff0, 0x00020000), rsB = __builtin_amdgcn_make_buffer_rsrc((void*)g.Bt, (short)0, 0x7ffffff0, 0x00020000);
    const unsigned ldsw = (unsigned)wid * 1024u;
    const int aoff = lds_byte(wr * 64 + fr, fq * 8), boff = lds_byte(wc * 32 + fr, fq * 8);
#define PG8_SA(b, h) (((b) * 2 + (h)) * HTB)
#define PG8_SB(b, h) ((4 + (b) * 2 + (h)) * HTB)
#define PG8_STAGE_A(bufoff, soff, voff) do { if (!(XP & 4)) _Pragma("unroll") for (int _i = 0; _i < 2; ++_i) \
        __builtin_amdgcn_raw_ptr_buffer_load_lds(rsA, (PG8_LAS void*)(lds + (bufoff) + ldsw + _i * 8192), 16, (int)(voff)[_i], (int)(soff), 0, 0); } while (0)
#define PG8_STAGE_B(bufoff, soff, voff) do { if (!(XP & 4)) _Pragma("unroll") for (int _i = 0; _i < 2; ++_i) \
        __builtin_amdgcn_raw_ptr_buffer_load_lds(rsB, (PG8_LAS void*)(lds + (bufoff) + ldsw + _i * 8192), 16, (int)(voff)[_i], (int)(soff), 0, 0); } while (0)
#define PG8_LDA(dst, b, h) do { if (!(XP & 2)) _Pragma("unroll") for (int m = 0; m < 4; ++m) _Pragma("unroll") for (int k = 0; k < 2; ++k) dst[m][k] = *(const PG8_LAS bf16x8*)(lds + PG8_SA(b, h) + aoff + m * 2048 + k * 1024); } while (0)
#define PG8_LDB(dst, b, h) do { if (!(XP & 2)) _Pragma("unroll") for (int n = 0; n < 2; ++n) _Pragma("unroll") for (int k = 0; k < 2; ++k) dst[n][k] = *(const PG8_LAS bf16x8*)(lds + PG8_SB(b, h) + boff + n * 2048 + k * 1024); } while (0)
#define PG8_MMA(ai, bj, At, Bt) do { if (!(XP & 8)) __builtin_amdgcn_s_setprio(1); _Pragma("unroll") for (int m = 0; m < 4; ++m) _Pragma("unroll") for (int n = 0; n < 2; ++n) _Pragma("unroll") for (int k = 0; k < 2; ++k) { \
        if (!(XP & 1)) acc[ai][bj][m][n] = __builtin_amdgcn_mfma_f32_16x16x32_bf16(Bt[n][k], At[m][k], acc[ai][bj][m][n], 0, 0, 0); else asm volatile("" :: "v"(Bt[n][k]), "v"(At[m][k])); } if (!(XP & 8)) __builtin_amdgcn_s_setprio(0); } while (0)
#define PG8_WAIT_V(n) do { if (!(XP & 16)) asm volatile("s_waitcnt vmcnt(" #n ")" ::: "memory"); } while (0)
#define PG8_WAIT_L(n) asm volatile("s_waitcnt lgkmcnt(" #n ")" ::: "memory")
#define PG8_BAR __builtin_amdgcn_s_barrier()
#define PG8_SCHED __builtin_amdgcn_sched_barrier(0)
    Unit cur, nxt; int ui = 0;
    if (!S.next(0, cur)) return;
    f32x4 acc[2][2][4][2];
#pragma unroll
    for (int a = 0; a < 2; ++a)
#pragma unroll
        for (int b = 0; b < 2; ++b)
#pragma unroll
            for (int m = 0; m < 4; ++m)
#pragma unroll
                for (int n = 0; n < 2; ++n) acc[a][b][m][n] = (f32x4){0.f, 0.f, 0.f, 0.f};
    bf16x8 At[4][2], B0[2][2], B1[2][2];
    if (XP & 2) { bf16x8 pat; _Pragma("unroll") for (int q = 0; q < 8; ++q) pat[q] = (short)(0x3c00 + ((tid * 37 + q * 11) & 0x3ff));
        _Pragma("unroll") for (int m = 0; m < 4; ++m) _Pragma("unroll") for (int k = 0; k < 2; ++k) At[m][k] = pat;
        _Pragma("unroll") for (int n = 0; n < 2; ++n) _Pragma("unroll") for (int k = 0; k < 2; ++k) { B0[n][k] = pat; B1[n][k] = pat; } }
    unsigned cA = (unsigned)cur.pm * tstepA + (unsigned)(cur.pn >> 1) * g.agrp_bytes, cB = (unsigned)cur.pn * tstepB;
    S.a_ready(cur);
    if constexpr (SP2) {
        PG8_STAGE_B(PG8_SB(0, 0), cB, voffB); PG8_STAGE_B(PG8_SB(0, 1), cB + hstepB, voffB); PG8_STAGE_A(PG8_SA(0, 0), cA, voffA); PG8_STAGE_A(PG8_SA(0, 1), cA + hstepA, voffA);
        if (wr == 1) PG8_BAR;
        PG8_WAIT_V(2); PG8_BAR;
        PG8_STAGE_B(PG8_SB(1, 0), cB + kstep, voffB); PG8_STAGE_A(PG8_SA(1, 0), cA + kstep, voffA); PG8_STAGE_B(PG8_SB(1, 1), cB + hstepB + kstep, voffB);
        PG8_WAIT_V(6); PG8_BAR;
    } else {
        PG8_STAGE_B(PG8_SB(0, 0), cB, voffB); PG8_STAGE_A(PG8_SA(0, 0), cA, voffA); PG8_STAGE_B(PG8_SB(0, 1), cB + hstepB, voffB); PG8_STAGE_A(PG8_SA(0, 1), cA + hstepA, voffA);
        if (wr == 1) PG8_BAR;
        PG8_WAIT_V(4); PG8_BAR;
        PG8_STAGE_B(PG8_SB(1, 0), cB + kstep, voffB); PG8_STAGE_A(PG8_SA(1, 0), cA + kstep, voffA); PG8_STAGE_B(PG8_SB(1, 1), cB + hstepB + kstep, voffB);
        PG8_WAIT_V(6); PG8_BAR;
    }
    for (;;) {
        const bool has_next = S.next(ui + 1, nxt);
        const unsigned nA = has_next ? (unsigned)nxt.pm * tstepA + (unsigned)(nxt.pn >> 1) * g.agrp_bytes : cA, nB = has_next ? (unsigned)nxt.pn * tstepB : cB;
        for (int t = 0; t < nt; t += 2) {
            const bool last = (t == nt - 2);
            const unsigned a1 = cA + (unsigned)(t + 1) * kstep;
            const unsigned a2 = last ? nA : cA + (unsigned)(t + 2) * kstep, b2 = last ? nB : cB + (unsigned)(t + 2) * kstep;
            const unsigned a3 = a2 + kstep, b3 = b2 + kstep;
            if (last && has_next) S.a_ready(nxt);
            if constexpr (SP2) {
            PG8_LDB(B0, 0, 0); PG8_LDB(B1, 0, 1); PG8_SCHED; PG8_LDA(At, 0, 0); PG8_STAGE_A(PG8_SA(1, 1), a1 + hstepA, voffA);
            PG8_WAIT_V(8); PG8_WAIT_L(0); PG8_BAR; PG8_MMA(0, 0, At, B0); PG8_MMA(0, 1, At, B1); PG8_BAR; PG8_SCHED;
            PG8_LDA(At, 0, 1); PG8_STAGE_B(PG8_SB(0, 0), b2, voffB); PG8_STAGE_B(PG8_SB(0, 1), b2 + hstepB, voffB); PG8_STAGE_A(PG8_SA(0, 0), a2, voffA);
            PG8_WAIT_V(8); PG8_WAIT_L(0); PG8_BAR; PG8_MMA(1, 0, At, B0); PG8_MMA(1, 1, At, B1); PG8_BAR; PG8_SCHED;
            PG8_LDB(B0, 1, 0); PG8_LDB(B1, 1, 1); PG8_SCHED; PG8_LDA(At, 1, 0); PG8_STAGE_A(PG8_SA(0, 1), a2 + hstepA, voffA);
            PG8_WAIT_V(8); PG8_WAIT_L(0); PG8_BAR; PG8_MMA(0, 0, At, B0); PG8_MMA(0, 1, At, B1); PG8_BAR; PG8_SCHED;
            PG8_LDA(At, 1, 1); PG8_STAGE_B(PG8_SB(1, 0), b3, voffB); PG8_STAGE_B(PG8_SB(1, 1), b3 + hstepB, voffB); PG8_STAGE_A(PG8_SA(1, 0), a3, voffA);
            PG8_WAIT_V(8); PG8_WAIT_L(0); PG8_BAR; PG8_MMA(1, 0, At, B0); PG8_MMA(1, 1, At, B1); PG8_BAR; PG8_SCHED;
            } else {
            PG8_LDB(B0, 0, 0); PG8_SCHED; PG8_LDA(At, 0, 0); PG8_STAGE_A(PG8_SA(1, 1), a1 + hstepA, voffA);
            PG8_WAIT_L(8); PG8_BAR; PG8_WAIT_L(0); PG8_MMA(0, 0, At, B0); PG8_BAR; PG8_SCHED;
            PG8_LDB(B1, 0, 1); PG8_STAGE_B(PG8_SB(0, 0), b2, voffB);
            PG8_BAR; PG8_WAIT_L(0); PG8_MMA(0, 1, At, B1); PG8_BAR;
            PG8_LDA(At, 0, 1); PG8_STAGE_A(PG8_SA(0, 0), a2, voffA);
            PG8_BAR; PG8_WAIT_L(0); PG8_MMA(1, 0, At, B0); PG8_BAR; PG8_SCHED;
            PG8_STAGE_B(PG8_SB(0, 1), b2 + hstepB, voffB);
            PG8_WAIT_V(6); PG8_BAR; PG8_MMA(1, 1, At, B1); PG8_BAR;
            PG8_LDB(B0, 1, 0); PG8_SCHED; PG8_LDA(At, 1, 0); PG8_STAGE_A(PG8_SA(0, 1), a2 + hstepA, voffA);
            PG8_WAIT_L(8); PG8_BAR; PG8_WAIT_L(0); PG8_MMA(0, 0, At, B0); PG8_BAR; PG8_SCHED;
            PG8_LDB(B1, 1, 1); PG8_STAGE_B(PG8_SB(1, 0), b3, voffB);
            PG8_BAR; PG8_WAIT_L(0); PG8_MMA(0, 1, At, B1); PG8_BAR;
            PG8_LDA(At, 1, 1); PG8_STAGE_A(PG8_SA(1, 0), a3, voffA);
            PG8_BAR; PG8_WAIT_L(0); PG8_MMA(1, 0, At, B0); PG8_BAR; PG8_SCHED;
            PG8_STAGE_B(PG8_SB(1, 1), b3 + hstepB, voffB);
            PG8_WAIT_V(6); PG8_BAR; PG8_MMA(1, 1, At, B1); PG8_BAR;
            }
        }
        if constexpr (ALIGN_EPI) { if (wr == 0) PG8_BAR; }
        E(acc, cur, wr, wc, fr, fq); S.done(cur);
        if (!has_next) break;
#pragma unroll
        for (int a = 0; a < 2; ++a)
#pragma unroll
            for (int b = 0; b < 2; ++b)
#pragma unroll
                for (int m = 0; m < 4; ++m)
#pragma unroll
                    for (int n = 0; n < 2; ++n) acc[a][b][m][n] = (f32x4){0.f, 0.f, 0.f, 0.f};
        cur = nxt; cA = nA; cB = nB; ++ui;
        if constexpr (ALIGN_EPI) { if (wr == 1) PG8_BAR; }
    }
    PG8_WAIT_V(0);
    if constexpr (!ALIGN_EPI) { if (wr == 0) PG8_BAR; }
    PG8_BAR;
#undef PG8_SA
#undef PG8_SB
#undef PG8_STAGE_A
#undef PG8_STAGE_B
#undef PG8_LDA
#undef PG8_LDB
#undef PG8_MMA
#undef PG8_WAIT_V
#undef PG8_WAIT_L
#undef PG8_BAR
#undef PG8_SCHED
}
}
#ifndef MK_SEGLEN
#define MK_SEGLEN 1024
#endif
constexpr int NWAVES = 8;
constexpr int BATCH = 2, SEQ = 8192, D = 2048, M = BATCH * SEQ, DFF = 5632, NFF2 = 2 * DFF, NPROJ = 4 * D, NMOD = 6 * D, DEPTH = 4;
constexpr int HEADS = 16, HD = 128, PGD = 512;
constexpr float EPS = 1e-6f;
constexpr int KC = 32, KR = D / KC;
constexpr int NPHASE = 24;

constexpr size_t MiB = 1u << 20;
constexpr size_t WS_CTL = 0, CTL_ZERO_BYTES = 64 * 1024;
constexpr size_t WS_PART = 1 * MiB;
constexpr size_t WS_VEC = 14 * MiB;
constexpr size_t WS_SS = 16 * MiB;
constexpr size_t WS_REC = 18 * MiB;
constexpr size_t WS_WPOOL = 36 * MiB, WS_WHOUT = 40 * MiB, WS_WHIN = 56 * MiB, WS_WFIN = 120 * MiB, WS_WFOUT = 296 * MiB;
constexpr size_t WS_X = 384 * MiB, WS_XG = 512 * MiB, WS_AOP = 576 * MiB, WS_HID = 640 * MiB, WS_PROJ = 816 * MiB, WS_END = 1072 * MiB;
constexpr int V_SHM = 0, V_SHF = V_SHM + DEPTH * 2 * D, V_GM = V_SHF + DEPTH * 2 * D, V_GF = V_GM + DEPTH * 2 * D, V_GATEM = V_GF + DEPTH * 2 * D, V_GATEF = V_GATEM + DEPTH * 2 * D,
              V_LB = V_GATEF + DEPTH * 2 * D, V_BIASP = V_LB + 2 * D, V_BIASF = V_BIASP + 2 * 2 * NPROJ, V_END = V_BIASF + DEPTH * 2 * NFF2;
static_assert((size_t)V_END * 4 <= 2 * MiB, "vec region");
constexpr int CW_TMO = 0, CW_BAR = 4096;
static_assert((size_t)(CW_BAR + 3456) * 4 <= CTL_ZERO_BYTES, "barrier words inside the per-call memset");

constexpr int RING_OFF = 0, RING_BYTES = 131072;
constexpr int LDSCTL_OFF = RING_BYTES, MISC_OFF = LDSCTL_OFF + 320;
constexpr int LDS_BYTES = 147456;

#define GAS __attribute__((address_space(1)))
#define LAS __attribute__((address_space(3)))
typedef unsigned short bf16;
typedef unsigned v4u __attribute__((ext_vector_type(4)));
typedef unsigned v2u __attribute__((ext_vector_type(2)));
typedef float f32x4 __attribute__((ext_vector_type(4)));
typedef GAS unsigned gu32;
#define RLX_AGENT __ATOMIC_RELAXED, __HIP_MEMORY_SCOPE_AGENT
#define LDS_WAIT() asm volatile("s_waitcnt lgkmcnt(0)" ::: "memory")
#define VM_WAIT() asm volatile("s_waitcnt vmcnt(0)" ::: "memory")
__device__ __forceinline__ unsigned f2bf(float f) { unsigned u = __builtin_bit_cast(unsigned, f); return (u + 0x7fffu + ((u >> 16) & 1u)) >> 16; }
__device__ __forceinline__ unsigned pk2(float lo, float hi) { return f2bf(lo) | (f2bf(hi) << 16); }
__device__ __forceinline__ float bf2f(unsigned short b) { return __builtin_bit_cast(float, (unsigned)b << 16); }
__device__ __forceinline__ float bflo(unsigned w) { return __builtin_bit_cast(float, w << 16); }
__device__ __forceinline__ float bfhi(unsigned w) { return __builtin_bit_cast(float, w & 0xffff0000u); }
typedef _Float16 h2_t __attribute__((ext_vector_type(2)));
typedef float f32x2_t __attribute__((ext_vector_type(2)));
__device__ __forceinline__ unsigned pkh2(float lo, float hi) { const f32x2_t v = {lo, hi}; return __builtin_bit_cast(unsigned, __builtin_convertvector(v, h2_t)); }
__device__ __forceinline__ f32x2_t unph2(unsigned w) { return __builtin_convertvector(__builtin_bit_cast(h2_t, w), f32x2_t); }
__device__ __forceinline__ float sigmoidf_(float v) { return __builtin_amdgcn_rcpf(1.0f + __expf(-v)); }

#define XB_TMO      128
#define XB_XCNT(j)  (256  + 64 * (j))
#define XB_XSUB(j)  (1280 + 64 * (j))
#define XB_XGEN(j)  (2304 + 64 * (j))
#define XB_TOP      3328
#define XB_TOPGEN   3392
#define XCD_BAR_WORDS 3456
#define XB_SPIN_CAP (1u << 18)

__device__ __forceinline__ unsigned xb_ld(unsigned* p)              { return __hip_atomic_load(p, __ATOMIC_RELAXED, __HIP_MEMORY_SCOPE_AGENT); }
__device__ __forceinline__ unsigned xb_add(unsigned* p, unsigned v) { return __hip_atomic_fetch_add(p, v, __ATOMIC_RELAXED, __HIP_MEMORY_SCOPE_AGENT); }
__device__ __forceinline__ unsigned xb_xcc_id() { return (unsigned)__builtin_amdgcn_s_getreg((3 << 11) | 20) & 0xFu; }
#define XB_SPIN(cond, bar) do { unsigned _sp = 0; while (cond) { __builtin_amdgcn_s_sleep(1); \
    if ((++_sp & 255u) == 0u) { if (xb_ld(&(bar)[XB_TMO])) break; if (_sp > XB_SPIN_CAP) { atomicAdd(&(bar)[XB_TMO], 1u); break; } } } } while (0)

struct XcdBarrier { unsigned* bar; unsigned x; volatile LAS unsigned* st; };

__device__ __forceinline__ XcdBarrier xcd_barrier_post(unsigned* bar, volatile LAS unsigned* st) {
    XcdBarrier b; b.bar = bar; b.x = xb_xcc_id(); b.st = st;
    if (threadIdx.x == 0) (void)xb_add(&bar[XB_XCNT(b.x)], 1u);
    return b;
}
__device__ __forceinline__ void xcd_barrier_complete(unsigned* bar, unsigned x, unsigned& nloc, unsigned& nx) {
    const unsigned G = gridDim.x * gridDim.y * gridDim.z;
    unsigned sum, cnt, mine, sp = 0u;
    for (;;) {
        sum = 0u; cnt = 0u; mine = 0u;
#pragma unroll
        for (unsigned j = 0; j < 16; ++j) { const unsigned c = xb_ld(&bar[XB_XCNT(j)]); sum += c; cnt += (c > 0u) ? 1u : 0u; mine = (j == x) ? c : mine; }
        if (sum == G) break;
        __builtin_amdgcn_s_sleep(1);
        if ((++sp & 255u) == 0u) { if (xb_ld(&bar[XB_TMO])) break; if (sp > XB_SPIN_CAP) { atomicAdd(&bar[XB_TMO], 1u); break; } }
    }
    nloc = mine > 0u ? mine : 1u; nx = cnt > 0u ? cnt : 1u;
}
__device__ __forceinline__ void xcd_barrier(const XcdBarrier& b, const int wave) {
    asm volatile("s_waitcnt vmcnt(0)" ::: "memory");
    __syncthreads();
    if (wave == 0 && __builtin_amdgcn_mbcnt_hi(~0u, __builtin_amdgcn_mbcnt_lo(~0u, 0u)) == 0) {
        unsigned* bar = b.bar;
        __builtin_amdgcn_s_waitcnt(0);
        unsigned nloc = b.st[0], nx = b.st[1];
        if (nloc == 0u) { xcd_barrier_complete(bar, b.x, nloc, nx); b.st[0] = nloc; b.st[1] = nx; }
        const unsigned old = xb_add(&bar[XB_XSUB(b.x)], 1u);
        const unsigned gen = old / nloc;
        if (old + 1u == (gen + 1u) * nloc) {
            __builtin_amdgcn_fence(__ATOMIC_RELEASE, "agent");
            asm volatile("s_waitcnt vmcnt(0)" ::: "memory");
            const unsigned og = xb_add(&bar[XB_TOP], 1u);
            const unsigned tg = og / nx;
            if (og + 1u == (tg + 1u) * nx) xb_add(&bar[XB_TOPGEN], 1u);
            else XB_SPIN(xb_ld(&bar[XB_TOPGEN]) == tg, bar);
            __builtin_amdgcn_fence(__ATOMIC_ACQUIRE, "agent");
            xb_add(&bar[XB_XGEN(b.x)], 1u);
            asm volatile("s_waitcnt vmcnt(0)" ::: "memory");
        } else {
            XB_SPIN(xb_ld(&bar[XB_XGEN(b.x)]) == gen, bar);
            __builtin_amdgcn_fence(__ATOMIC_ACQUIRE, "agent");
            asm volatile("s_waitcnt vmcnt(0)" ::: "memory");
        }
    }
    __syncthreads();
}

struct Frame {
    LAS unsigned char* lds;
    int tid, lane, wave, G;
    const float *x, *c, *gmix, *gffn, *wada, *bada, *poolw, *pools, *hwin, *hwout, *hgain, *hlb, *wfin, *wfout, *fgain;
    float* out; unsigned char* ws;
    float* vec;
};
__device__ __forceinline__ int lane_id() { int l = __builtin_amdgcn_mbcnt_hi(~0u, __builtin_amdgcn_mbcnt_lo(~0u, 0u)); asm volatile("" : "+v"(l)); return l; }
__device__ __forceinline__ float wave_sum(float v) {
#pragma unroll
    for (int o = 1; o < 64; o <<= 1) v += __shfl_xor(v, o);
    return v;
}

struct CvtTile { f32x4 w[8]; };
__device__ __forceinline__ void cvt_load(CvtTile& t, const float* W, int N, int k0, int n0_src, int lane) {
#pragma unroll
    for (int i = 0; i < 8; ++i) t.w[i] = *(const GAS f32x4*)(W + (size_t)(k0 + 8 * i + (lane >> 3)) * N + n0_src + 4 * (lane & 7));
}
template <bool BIAS>
__device__ __forceinline__ void cvt_store(const CvtTile& t, bf16* WT, int K, int k0, int n0_dst, LAS float* scr, int lane, const LAS float* shL, int Ktot, float (&bacc)[2][4]) {
#pragma unroll
    for (int i = 0; i < 8; ++i) { LAS float* p = scr + (8 * i + (lane >> 3)) * 33 + 4 * (lane & 7); p[0] = t.w[i].x; p[1] = t.w[i].y; p[2] = t.w[i].z; p[3] = t.w[i].w; }
    LDS_WAIT(); asm volatile("" ::: "memory");
    const int c = lane & 7;
    f32x4 s0a, s0b, s1a, s1b;
    if (BIAS) { s0a = *(const LAS f32x4*)(shL + k0 + 8 * c); s0b = *(const LAS f32x4*)(shL + k0 + 8 * c + 4); s1a = *(const LAS f32x4*)(shL + Ktot + k0 + 8 * c); s1b = *(const LAS f32x4*)(shL + Ktot + k0 + 8 * c + 4); }
#pragma unroll
    for (int j = 0; j < 4; ++j) { const int n = (lane >> 3) + 8 * j; const LAS float* s = scr + (8 * c) * 33 + n;
        const float v0 = s[0 * 33], v1 = s[1 * 33], v2 = s[2 * 33], v3 = s[3 * 33], v4 = s[4 * 33], v5 = s[5 * 33], v6 = s[6 * 33], v7 = s[7 * 33];
        if (BIAS) { bacc[0][j] += (v0 * s0a.x + v1 * s0a.y) + (v2 * s0a.z + v3 * s0a.w) + (v4 * s0b.x + v5 * s0b.y) + (v6 * s0b.z + v7 * s0b.w);
                    bacc[1][j] += (v0 * s1a.x + v1 * s1a.y) + (v2 * s1a.z + v3 * s1a.w) + (v4 * s1b.x + v5 * s1b.y) + (v6 * s1b.z + v7 * s1b.w); }
        v4u o; o.x = pg8::cvt_pk_bf16(v0, v1); o.y = pg8::cvt_pk_bf16(v2, v3); o.z = pg8::cvt_pk_bf16(v4, v5); o.w = pg8::cvt_pk_bf16(v6, v7);
        *(GAS v4u*)(WT + (size_t)(n0_dst + n) * K + k0 + 8 * c) = o; }
    LDS_WAIT(); asm volatile("" ::: "memory");
}
__device__ __forceinline__ void convert_matrix(Frame& F, const float* W, int K, int N, bf16* WT, LAS float* scr, int& itbase) {
    const int gw = blockIdx.x * NWAVES + F.wave, NGW = F.G * NWAVES;
    const int nblk = N / 32, nitems = (K / 64) * nblk;
    int it = (gw - itbase % NGW + NGW) % NGW;
    float dummy[2][4];
    CvtTile cur, nxt;
    if (it < nitems) cvt_load(nxt, W, N, 64 * (it / nblk), 32 * (it % nblk), F.lane);
    for (; it < nitems; it += NGW) {
        cur = nxt; const int itn = it + NGW;
        if (itn < nitems) cvt_load(nxt, W, N, 64 * (itn / nblk), 32 * (itn % nblk), F.lane);
        cvt_store<false>(cur, WT, K, 64 * (it / nblk), 32 * (it % nblk), scr, F.lane, nullptr, 0, dummy);
    }
    itbase += nitems;
}

__device__ __forceinline__ void phase_p0a(Frame& F) {
    const int gw = blockIdx.x * NWAVES + F.wave, NGW = F.G * NWAVES, gt = blockIdx.x * (NWAVES * 64) + F.tid;
    LAS float* condL = (LAS float*)(F.lds + RING_OFF);
    for (int i = F.tid; i < 2 * D; i += NWAVES * 64) { const float cv = F.c[i]; condL[i] = cv * sigmoidf_(cv); }
    __syncthreads();
    float* part = (float*)(F.ws + WS_PART);
    for (int it = gw; it < DEPTH * KC * (NMOD / 256); it += NGW) {
        const int ns = it % (NMOD / 256), kc = (it / (NMOD / 256)) % KC, l = it / ((NMOD / 256) * KC);
        const float* W = F.wada + ((size_t)l * D + (size_t)kc * KR) * NMOD + ns * 256 + F.lane * 4;
        f32x4 a0 = {0.f, 0.f, 0.f, 0.f}, a1 = {0.f, 0.f, 0.f, 0.f};
        for (int k = 0; k < KR; k += 8) {
            f32x4 w[8];
#pragma unroll
            for (int j = 0; j < 8; ++j) w[j] = *(const GAS f32x4*)(W + (size_t)(k + j) * NMOD);
#pragma unroll
            for (int j = 0; j < 8; ++j) { const float c0 = condL[kc * KR + k + j], c1 = condL[D + kc * KR + k + j]; a0 += c0 * w[j]; a1 += c1 * w[j]; }
        }
        *(GAS f32x4*)(part + ((size_t)(kc * DEPTH + l) * 2 + 0) * NMOD + ns * 256 + F.lane * 4) = a0;
        *(GAS f32x4*)(part + ((size_t)(kc * DEPTH + l) * 2 + 1) * NMOD + ns * 256 + F.lane * 4) = a1;
    }
    if (gt < D) {
        const float l0 = F.hlb[gt], l1 = F.hlb[D + gt], l2 = F.hlb[2 * D + gt], l3 = F.hlb[3 * D + gt];
        const float mx = fmaxf(fmaxf(l0, l1), fmaxf(l2, l3));
        const float e0 = __expf(l0 - mx), e1 = __expf(l1 - mx), e2 = __expf(l2 - mx), e3 = __expf(l3 - mx), inv = 1.0f / (e0 + e1 + e2 + e3);
        F.vec[V_LB + gt] = e1 * inv; F.vec[V_LB + D + gt] = (e1 + e2 + e3) * inv;
    }
    float* ss = (float*)(F.ws + WS_SS);
    for (int m = gw; m < M; m += NGW) {
        const GAS f32x4* xr = (const GAS f32x4*)(F.x + (size_t)m * D) + F.lane; float s = 0.f;
#pragma unroll
        for (int j = 0; j < 8; ++j) { const f32x4 v = xr[64 * j]; s += (v.x * v.x + v.y * v.y) + (v.z * v.z + v.w * v.w); }
        s = wave_sum(s);
        if (F.lane < 32) ss[(size_t)m * 32 + F.lane] = (F.lane == 0) ? s : 0.f;
    }
    __syncthreads();
    LAS float* scr = (LAS float*)(F.lds + RING_OFF + F.wave * 16384);
    int itbase = 0;
    for (int j = 0; j < 8; ++j) convert_matrix(F, F.poolw + (size_t)j * PGD * PGD, PGD, PGD, (bf16*)(F.ws + WS_WPOOL) + (size_t)j * PGD * PGD, scr, itbase);
    for (int j = 0; j < 2; ++j) convert_matrix(F, F.hwout + (size_t)j * D * D, D, D, (bf16*)(F.ws + WS_WHOUT) + (size_t)j * D * D, scr, itbase);
    for (int j = 0; j < DEPTH; ++j) convert_matrix(F, F.wfout + (size_t)j * DFF * D, DFF, D, (bf16*)(F.ws + WS_WFOUT) + (size_t)j * DFF * D, scr, itbase);
}
__device__ __forceinline__ void phase_p0b(Frame& F) {
    const int gt = blockIdx.x * (NWAVES * 64) + F.tid;
    if (gt >= DEPTH * 2 * (D / 4) * 6) return;
    const int cq = gt % (D / 4), r = gt / (D / 4), j = r % 6, b = (r / 6) % 2, l = r / 12, col = cq * 4;
    const float* part = (const float*)(F.ws + WS_PART);
    f32x4 s = *(const GAS f32x4*)(F.bada + (size_t)l * NMOD + j * D + col);
    f32x4 pv[KC];
#pragma unroll
    for (int kc = 0; kc < KC; ++kc) pv[kc] = *(const GAS f32x4*)(part + ((size_t)(kc * DEPTH + l) * 2 + b) * NMOD + j * D + col);
#pragma unroll
    for (int kc = 0; kc < KC; ++kc) s += pv[kc];
    const int vo = (l * 2 + b) * D + col;
    if (j == 0) *(GAS f32x4*)(F.vec + V_SHM + vo) = s;
    else if (j == 1) *(GAS f32x4*)(F.vec + V_GM + vo) = *(const GAS f32x4*)(F.gmix + (size_t)l * D + col) * (1.0f + s);
    else if (j == 2) { if ((l & 1) == 0) s = s * *(const GAS f32x4*)(F.pools + (size_t)(l >> 1) * D + col); *(GAS f32x4*)(F.vec + V_GATEM + vo) = s; }
    else if (j == 3) *(GAS f32x4*)(F.vec + V_SHF + vo) = s;
    else if (j == 4) *(GAS f32x4*)(F.vec + V_GF + vo) = *(const GAS f32x4*)(F.gffn + (size_t)l * D + col) * (1.0f + s);
    else *(GAS f32x4*)(F.vec + V_GATEF + vo) = s;
}
__device__ __forceinline__ void phase_p0c(Frame& F) {
    constexpr int NB_H = NPROJ / 256, NB_F = NFF2 / 256;
    constexpr int NITEMS = 2 * NB_H + DEPTH * NB_F;
    LAS float* shL = (LAS float*)(F.lds + RING_OFF);
    LAS float* scr = (LAS float*)(F.lds + RING_OFF + 16384 + F.wave * 12288);
    for (int bi = blockIdx.x; bi < NITEMS; bi += F.G) {
        const bool is_h = bi < 2 * NB_H;
        const int mi = is_h ? bi / NB_H : (bi - 2 * NB_H) / NB_F, grp = is_h ? bi % NB_H : (bi - 2 * NB_H) % NB_F;
        const int layer = is_h ? 2 * mi + 1 : mi;
        const int N = is_h ? NPROJ : NFF2;
        const float* W = is_h ? F.hwin + (size_t)mi * D * NPROJ : F.wfin + (size_t)mi * D * NFF2;
        bf16* WT = is_h ? (bf16*)(F.ws + WS_WHIN) + (size_t)mi * NPROJ * D : (bf16*)(F.ws + WS_WFIN) + (size_t)mi * NFF2 * D;
        const float* shv = F.vec + (is_h ? V_SHM : V_SHF) + (size_t)layer * 2 * D;
        float* biasv = F.vec + (is_h ? V_BIASP + (size_t)mi * 2 * NPROJ : V_BIASF + (size_t)mi * 2 * NFF2);
        __syncthreads();
        for (int i = F.tid; i < 2 * D; i += NWAVES * 64) shL[i] = shv[i];
        __syncthreads();
        const int n0_dst = grp * 256 + F.wave * 32;
        int n0_src = n0_dst;
        if (!is_h) { const int pn = n0_dst / 256, within = n0_dst % 256, bj = within / 128, j = within % 128; n0_src = bj * DFF + pn * 128 + j; }
        float bacc[2][4];
#pragma unroll
        for (int q = 0; q < 2; ++q)
#pragma unroll
            for (int jj = 0; jj < 4; ++jj) bacc[q][jj] = 0.f;
        CvtTile cur, nxt, nx2;
        cvt_load(nxt, W, N, 0, n0_src, F.lane); cvt_load(nx2, W, N, 64, n0_src, F.lane);
        for (int kb = 0; kb < D / 64; ++kb) {
            cur = nxt; nxt = nx2;
            if (kb + 2 < D / 64) cvt_load(nx2, W, N, 64 * (kb + 2), n0_src, F.lane);
            cvt_store<true>(cur, WT, D, 64 * kb, n0_dst, scr, F.lane, shL, D, bacc);
        }
#pragma unroll
        for (int q = 0; q < 2; ++q)
#pragma unroll
            for (int jj = 0; jj < 4; ++jj) { float v = bacc[q][jj]; v += __shfl_xor(v, 1); v += __shfl_xor(v, 2); v += __shfl_xor(v, 4);
                if ((F.lane & 7) == 0) biasv[q * N + n0_dst + (F.lane >> 3) + 8 * jj] = v; }
    }
}
template <bool XF32>
__device__ __forceinline__ void load_x8(const void* xsrc, size_t eoff, float (&v)[8]) {
    if (XF32) { const f32x4 a = *(const GAS f32x4*)((const float*)xsrc + eoff), b = *(const GAS f32x4*)((const float*)xsrc + eoff + 4);
        v[0] = a.x; v[1] = a.y; v[2] = a.z; v[3] = a.w; v[4] = b.x; v[5] = b.y; v[6] = b.z; v[7] = b.w; }
    else { const v4u a = *(const GAS v4u*)((const unsigned short*)xsrc + eoff); const f32x2_t p0 = unph2(a.x), p1 = unph2(a.y), p2 = unph2(a.z), p3 = unph2(a.w);
        v[0] = p0.x; v[1] = p0.y; v[2] = p1.x; v[3] = p1.y; v[4] = p2.x; v[5] = p2.y; v[6] = p3.x; v[7] = p3.y; }
}
template <bool XF32>
__device__ __forceinline__ void phase_poolprep(Frame& F, int layer, const void* xsrc) {
    LAS float* rs = (LAS float*)(F.lds + RING_OFF);
    const float* ss = (const float*)(F.ws + WS_SS);
    bf16* dst = (bf16*)(F.ws + WS_AOP);
    for (int ts = blockIdx.x; ts < M / 64; ts += F.G) {
        const int r0 = ts * 64, b = r0 / SEQ, t0 = r0 % SEQ;
        __syncthreads();
        if (F.tid < 80) { const int row = r0 - 16 + F.tid; float v = 0.f;
            if (t0 - 16 + F.tid >= 0) { float s = 0.f;
#pragma unroll
                for (int j = 0; j < 8; ++j) { const f32x4 a = *(const GAS f32x4*)(ss + (size_t)row * 32 + 4 * j); s += (a.x + a.y) + (a.z + a.w); }
                v = rsqrtf(s * (1.0f / D) + EPS); }
            rs[F.tid] = v; }
        __syncthreads();
        const int half = F.tid >> 8, col = (F.tid & 255) * 8, g = col >> 9, w = 2 << g, rb = r0 + half * 32, tb = t0 + half * 32, ib = 16 + half * 32;
        float gm[8], sh[8], S[8], xv[8];
        { const f32x4 a = *(const GAS f32x4*)(F.vec + V_GM + (layer * 2 + b) * D + col), c = *(const GAS f32x4*)(F.vec + V_GM + (layer * 2 + b) * D + col + 4);
          gm[0] = a.x; gm[1] = a.y; gm[2] = a.z; gm[3] = a.w; gm[4] = c.x; gm[5] = c.y; gm[6] = c.z; gm[7] = c.w; }
        { const f32x4 a = *(const GAS f32x4*)(F.vec + V_SHM + (layer * 2 + b) * D + col), c = *(const GAS f32x4*)(F.vec + V_SHM + (layer * 2 + b) * D + col + 4);
          sh[0] = a.x; sh[1] = a.y; sh[2] = a.z; sh[3] = a.w; sh[4] = c.x; sh[5] = c.y; sh[6] = c.z; sh[7] = c.w; }
#pragma unroll
        for (int e = 0; e < 8; ++e) S[e] = 0.f;
        for (int j = 1; j < w; ++j) { if (tb - j >= 0) { load_x8<XF32>(xsrc, (size_t)(rb - j) * D + col, xv); const float r = rs[ib - j];
#pragma unroll
            for (int e = 0; e < 8; ++e) S[e] += xv[e] * r * gm[e] + sh[e]; } }
#pragma unroll 4
        for (int i = 0; i < 32; ++i) {
            const int t = tb + i;
            load_x8<XF32>(xsrc, (size_t)(rb + i) * D + col, xv);
            const float r = rs[ib + i]; const float inv = __builtin_amdgcn_rcpf((float)((t + 1 < w) ? (t + 1) : w));
            float dv[8];
#pragma unroll
            for (int e = 0; e < 8; ++e) { const float h = xv[e] * r * gm[e] + sh[e]; S[e] += h; dv[e] = S[e] * inv - h; }
            v4u o; o.x = pg8::cvt_pk_bf16(dv[0], dv[1]); o.y = pg8::cvt_pk_bf16(dv[2], dv[3]); o.z = pg8::cvt_pk_bf16(dv[4], dv[5]); o.w = pg8::cvt_pk_bf16(dv[6], dv[7]);
            *(GAS v4u*)(dst + (size_t)(rb + i) * D + col) = o;
            if (t - w + 1 >= 0) { load_x8<XF32>(xsrc, (size_t)(rb + i - w + 1) * D + col, xv); const float ro = rs[ib + i - w + 1];
#pragma unroll
                for (int e = 0; e < 8; ++e) S[e] -= xv[e] * ro * gm[e] + sh[e]; }
        }
    }
}
typedef short bf16x8_t __attribute__((ext_vector_type(8)));
__device__ __forceinline__ bf16x8_t frag2(const LAS unsigned char* p0, const LAS unsigned char* p1) {
    const v2u a = *(const LAS v2u*)p0, b = *(const LAS v2u*)p1; v4u r; r.x = a.x; r.y = a.y; r.z = b.x; r.w = b.y; return __builtin_bit_cast(bf16x8_t, r);
}
typedef short s16x4_t __attribute__((ext_vector_type(4)));
__device__ __forceinline__ bf16x8_t fragtr(const LAS unsigned char* p0, const LAS unsigned char* p1) {
    const s16x4_t a = __builtin_amdgcn_ds_read_tr16_b64_v4i16((LAS s16x4_t*)p0), b = __builtin_amdgcn_ds_read_tr16_b64_v4i16((LAS s16x4_t*)p1);
    const v2u ua = __builtin_bit_cast(v2u, a), ub = __builtin_bit_cast(v2u, b); v4u r; r.x = ua.x; r.y = ua.y; r.z = ub.x; r.w = ub.y; return __builtin_bit_cast(bf16x8_t, r);
}
__device__ __forceinline__ bf16x8_t packf(const f32x4 lo, const f32x4 hi) {
    v4u r; r.x = pg8::cvt_pk_bf16(lo.x, lo.y); r.y = pg8::cvt_pk_bf16(lo.z, lo.w); r.z = pg8::cvt_pk_bf16(hi.x, hi.y); r.w = pg8::cvt_pk_bf16(hi.z, hi.w); return __builtin_bit_cast(bf16x8_t, r);
}
template <int CTRL, int ROWMASK> __device__ __forceinline__ float dpp_f(float v) { return __builtin_bit_cast(float, __builtin_amdgcn_update_dpp(0, __builtin_bit_cast(int, v), CTRL, ROWMASK, 0xF, false)); }
namespace recl { constexpr int C = 32, QS = 272, TS = 288, OSS = 528;
    constexpr int DEC = 0, QH = 512, KT = QH + 32 * QS, KH = KT + 32 * QS, V = KH + 32 * TS, OS = V + 32 * TS, SET = OS + 32 * OSS; }
template <bool P2>
__device__ __forceinline__ void rec_prep(LAS unsigned char* lds, const v4u cq, const v4u clf, const v4u cv, const int lane, const int pt, const int pd8, float (&btot)[8]) {
    using namespace recl;
    float lf[8], x[8], bend[8];
    lf[0] = bflo(clf.x); lf[1] = bfhi(clf.x); lf[2] = bflo(clf.y); lf[3] = bfhi(clf.y); lf[4] = bflo(clf.z); lf[5] = bfhi(clf.z); lf[6] = bflo(clf.w); lf[7] = bfhi(clf.w);
#pragma unroll
    for (int e = 0; e < 8; ++e) { float xx = lf[e];
        xx += dpp_f<0x111, 0xF>(xx); xx += dpp_f<0x112, 0xF>(xx); xx += dpp_f<0x114, 0xF>(xx); xx += dpp_f<0x118, 0xF>(xx); xx += dpp_f<0x142, 0xA>(xx);
        x[e] = xx; const float e0v = __builtin_bit_cast(float, __builtin_amdgcn_readlane(__builtin_bit_cast(int, xx), 31)), e1v = __builtin_bit_cast(float, __builtin_amdgcn_readlane(__builtin_bit_cast(int, xx), 63));
        bend[e] = (lane < 32) ? e0v : e1v; }
    float qh[8], kt[8], kh[8];
    { float qq[8];
      qq[0] = bflo(cq.x); qq[1] = bfhi(cq.x); qq[2] = bflo(cq.y); qq[3] = bfhi(cq.y); qq[4] = bflo(cq.z); qq[5] = bfhi(cq.z); qq[6] = bflo(cq.w); qq[7] = bfhi(cq.w);
#pragma unroll
      for (int e = 0; e < 8; ++e) { const float bb = x[e], k = 1.0f - __expf(lf[e]);
          kh[e] = k * __expf(bend[e] - bb);
          if (P2) { qh[e] = qq[e] * __expf(bb); kt[e] = k * __expf(-bb); } else { qh[e] = 0.f; kt[e] = 0.f; btot[e] += bend[e]; } } }
    if (P2) {
        v4u wq, wk; wq.x = pg8::cvt_pk_bf16(qh[0], qh[1]); wq.y = pg8::cvt_pk_bf16(qh[2], qh[3]); wq.z = pg8::cvt_pk_bf16(qh[4], qh[5]); wq.w = pg8::cvt_pk_bf16(qh[6], qh[7]);
        wk.x = pg8::cvt_pk_bf16(kt[0], kt[1]); wk.y = pg8::cvt_pk_bf16(kt[2], kt[3]); wk.z = pg8::cvt_pk_bf16(kt[4], kt[5]); wk.w = pg8::cvt_pk_bf16(kt[6], kt[7]);
        *(LAS v4u*)(lds + QH + pt * QS + pd8 * 2) = wq; *(LAS v4u*)(lds + KT + pt * QS + pd8 * 2) = wk;
    }
    { v4u wh; wh.x = pg8::cvt_pk_bf16(kh[0], kh[1]); wh.y = pg8::cvt_pk_bf16(kh[2], kh[3]); wh.z = pg8::cvt_pk_bf16(kh[4], kh[5]); wh.w = pg8::cvt_pk_bf16(kh[6], kh[7]);
      *(LAS v4u*)(lds + KH + pt * TS + pd8 * 2) = wh; *(LAS v4u*)(lds + V + pt * TS + pd8 * 2) = cv; }
    if (pt == 31) { *(LAS f32x4*)(lds + DEC + pd8 * 4) = (f32x4){__expf(bend[0]), __expf(bend[1]), __expf(bend[2]), __expf(bend[3])};
                    *(LAS f32x4*)(lds + DEC + (pd8 + 4) * 4) = (f32x4){__expf(bend[4]), __expf(bend[5]), __expf(bend[6]), __expf(bend[7])}; }
}
template <bool P2, int RX = 0>
__device__ __forceinline__ void phase_rec(Frame& F, int j) {
    using namespace recl;
    constexpr int SEGLEN = MK_SEGLEN, NCH = SEGLEN / C, NSEG = SEQ / SEGLEN;
    static_assert(2 * SET <= RING_BYTES, "rec LDS");
    const int item = blockIdx.x; if (item >= BATCH * HEADS * NSEG) return;
    const int seq = item / NSEG, p = item % NSEG, b = seq >> 4, h = seq & 15;
    if (!P2 && p == NSEG - 1) return;
    LAS unsigned char* lds0 = F.lds + RING_OFF;
    const int tid = F.tid, lane = F.lane, w = F.wave, fr = lane & 15, g = lane >> 4;
    const int t = tid >> 4, d8 = (tid & 15) * 8;
    const int pt = lane & 31, pd8 = 16 * w + 8 * (lane >> 5);
    const bf16* Q = (const bf16*)(F.ws + WS_PROJ); const bf16* LF = Q + (size_t)M * D; const bf16* V_ = LF + (size_t)M * D; const bf16* Gt = V_ + (size_t)M * D;
    bf16* O = (bf16*)(F.ws + WS_AOP);
    float* Lst = (float*)(F.ws + WS_REC); float* DT = (float*)(F.ws + WS_REC + 16 * MiB);
    const size_t rowb = (size_t)b * SEQ + (size_t)p * SEGLEN;
    const size_t e0 = (rowb + t) * D + h * HD + d8, pe0 = (rowb + pt) * D + h * HD + pd8;
    f32x4 S[8];
#pragma unroll
    for (int i = 0; i < 8; ++i) S[i] = (f32x4){0.f, 0.f, 0.f, 0.f};
    float btot[8];
#pragma unroll
    for (int e = 0; e < 8; ++e) btot[e] = 0.f;
    if (P2 && p > 0) {
        f32x4 ndc[8], nlv[8];
#pragma unroll
        for (int dt = 0; dt < 8; ++dt) { const int it2 = seq * NSEG;
            ndc[dt] = *(const GAS f32x4*)(DT + (size_t)it2 * HD + 16 * dt + 4 * g); nlv[dt] = *(const GAS f32x4*)(Lst + ((((size_t)it2 * 8 + w) * 8 + dt) * 64 + lane) * 4); }
        for (int pp = 0; pp < p; ++pp) {
            f32x4 cdc[8], clv[8];
#pragma unroll
            for (int dt = 0; dt < 8; ++dt) { cdc[dt] = ndc[dt]; clv[dt] = nlv[dt]; }
            if (pp + 1 < p) { const int it2 = seq * NSEG + pp + 1;
#pragma unroll
                for (int dt = 0; dt < 8; ++dt) { ndc[dt] = *(const GAS f32x4*)(DT + (size_t)it2 * HD + 16 * dt + 4 * g); nlv[dt] = *(const GAS f32x4*)(Lst + ((((size_t)it2 * 8 + w) * 8 + dt) * 64 + lane) * 4); } }
#pragma unroll
            for (int dt = 0; dt < 8; ++dt) S[dt] = S[dt] * cdc[dt] + clv[dt];
        }
    }
    f32x4 ga = {0.f, 0.f, 0.f, 0.f}, gb = ga;
    if (P2) { ga = *(const GAS f32x4*)(F.hgain + (size_t)j * D + h * HD + d8); gb = *(const GAS f32x4*)(F.hgain + (size_t)j * D + h * HD + d8 + 4); }
    const v4u z4u = {0u, 0u, 0u, 0u};
    { const v4u q0 = P2 ? *(const GAS v4u*)(Q + pe0) : z4u, l0 = *(const GAS v4u*)(LF + pe0), v0 = *(const GAS v4u*)(V_ + pe0);
      rec_prep<P2>(lds0, q0, l0, v0, lane, pt, pd8, btot); }
    v4u nq = z4u, nlf = z4u, nv = z4u;
    if (NCH > 1) { const size_t adv = (size_t)C * D; nlf = *(const GAS v4u*)(LF + pe0 + adv); nv = *(const GAS v4u*)(V_ + pe0 + adv); if (P2) nq = *(const GAS v4u*)(Q + pe0 + adv); }
    __syncthreads();
    for (int c = 0; c < NCH; ++c) {
        LAS unsigned char* lds = lds0 + (c & 1) * SET;
        LAS unsigned char* ldn = lds0 + ((c + 1) & 1) * SET;
        v4u cg = z4u; if (P2) cg = *(const GAS v4u*)(Gt + e0 + (size_t)c * C * D);
        const v4u cq = nq, clf = nlf, cv = nv;
        if (c + 2 < NCH) { const size_t adv = (size_t)(c + 2) * C * D;
            nlf = *(const GAS v4u*)(LF + pe0 + adv); nv = *(const GAS v4u*)(V_ + pe0 + adv); if (P2) nq = *(const GAS v4u*)(Q + pe0 + adv); }
        if (c + 1 < NCH) rec_prep<P2>(ldn, cq, clf, cv, lane, pt, pd8, btot);
        if (!(RX & 1)) {
        const int trq = fr >> 2, trp = fr & 3;
        const bf16x8_t vf = fragtr(lds + V + (4 * g + trq) * TS + (16 * w + 4 * trp) * 2, lds + V + (16 + 4 * g + trq) * TS + (16 * w + 4 * trp) * 2);
        if (P2) {
            bf16x8_t qf[2][4];
#pragma unroll
            for (int tt = 0; tt < 2; ++tt)
#pragma unroll
                for (int ks = 0; ks < 4; ++ks) qf[tt][ks] = frag2(lds + QH + (16 * tt + fr) * QS + (32 * ks + 4 * g) * 2, lds + QH + (16 * tt + fr) * QS + (32 * ks + 16 + 4 * g) * 2);
            f32x4 at0 = {0.f, 0.f, 0.f, 0.f}, at1 = at0, at2 = at0, o0 = at0, o1 = at0;
#pragma unroll
            for (int ks = 0; ks < 4; ++ks) { const bf16x8_t sf = packf(S[2 * ks], S[2 * ks + 1]);
                o0 = __builtin_amdgcn_mfma_f32_16x16x32_bf16(qf[0][ks], sf, o0, 0, 0, 0);
                o1 = __builtin_amdgcn_mfma_f32_16x16x32_bf16(qf[1][ks], sf, o1, 0, 0, 0); }
#pragma unroll
            for (int ks = 0; ks < 4; ++ks) {
                const bf16x8_t k0 = frag2(lds + KT + fr * QS + (32 * ks + 4 * g) * 2, lds + KT + fr * QS + (32 * ks + 16 + 4 * g) * 2);
                const bf16x8_t k1 = frag2(lds + KT + (16 + fr) * QS + (32 * ks + 4 * g) * 2, lds + KT + (16 + fr) * QS + (32 * ks + 16 + 4 * g) * 2);
                at0 = __builtin_amdgcn_mfma_f32_16x16x32_bf16(k0, qf[0][ks], at0, 0, 0, 0);
                at1 = __builtin_amdgcn_mfma_f32_16x16x32_bf16(k0, qf[1][ks], at1, 0, 0, 0);
                at2 = __builtin_amdgcn_mfma_f32_16x16x32_bf16(k1, qf[1][ks], at2, 0, 0, 0);
            }
#pragma unroll
            for (int r = 0; r < 4; ++r) { const bool keep = (4 * g + r) <= fr; at0[r] = keep ? at0[r] : 0.f; at2[r] = keep ? at2[r] : 0.f; }
            const f32x4 z4 = {0.f, 0.f, 0.f, 0.f};
            const bf16x8_t af0 = packf(at0, z4), af1 = packf(at1, at2);
            o0 = __builtin_amdgcn_mfma_f32_16x16x32_bf16(af0, vf, o0, 0, 0, 0);
            o1 = __builtin_amdgcn_mfma_f32_16x16x32_bf16(af1, vf, o1, 0, 0, 0);
#pragma unroll
            for (int r = 0; r < 4; ++r) { *(LAS float*)(lds + OS + (4 * g + r) * OSS + (16 * w + fr) * 4) = o0[r]; *(LAS float*)(lds + OS + (16 + 4 * g + r) * OSS + (16 * w + fr) * 4) = o1[r]; }
        }
#pragma unroll
        for (int dt = 0; dt < 8; ++dt) {
            const bf16x8_t hf = fragtr(lds + KH + (4 * g + trq) * TS + (16 * dt + 4 * trp) * 2, lds + KH + (16 + 4 * g + trq) * TS + (16 * dt + 4 * trp) * 2);
            const f32x4 dc = *(const LAS f32x4*)(lds + DEC + (16 * dt + 4 * g) * 4);
            S[dt] = __builtin_amdgcn_mfma_f32_16x16x32_bf16(hf, vf, S[dt] * dc, 0, 0, 0);
        }
        }
        __syncthreads();
        if (P2 && !(RX & 4)) {
            const f32x4 oa = *(const LAS f32x4*)(lds + OS + t * OSS + d8 * 4), ob = *(const LAS f32x4*)(lds + OS + t * OSS + (d8 + 4) * 4);
            float sq = (oa.x * oa.x + oa.y * oa.y) + (oa.z * oa.z + oa.w * oa.w) + (ob.x * ob.x + ob.y * ob.y) + (ob.z * ob.z + ob.w * ob.w);
            sq += __shfl_xor(sq, 1); sq += __shfl_xor(sq, 2); sq += __shfl_xor(sq, 4); sq += __shfl_xor(sq, 8);
            const float rstd = rsqrtf(sq * (1.0f / HD) + EPS);
            const float r0 = oa.x * rstd * ga.x * bflo(cg.x), r1 = oa.y * rstd * ga.y * bfhi(cg.x), r2 = oa.z * rstd * ga.z * bflo(cg.y), r3 = oa.w * rstd * ga.w * bfhi(cg.y);
            const float r4 = ob.x * rstd * gb.x * bflo(cg.z), r5 = ob.y * rstd * gb.y * bfhi(cg.z), r6 = ob.z * rstd * gb.z * bflo(cg.w), r7 = ob.w * rstd * gb.w * bfhi(cg.w);
            v4u wo; wo.x = pg8::cvt_pk_bf16(r0, r1); wo.y = pg8::cvt_pk_bf16(r2, r3); wo.z = pg8::cvt_pk_bf16(r4, r5); wo.w = pg8::cvt_pk_bf16(r6, r7);
            *(GAS v4u*)(O + e0 + (size_t)c * C * D) = wo;
        }
    }
    if (!P2) {
#pragma unroll
        for (int dt = 0; dt < 8; ++dt) *(GAS f32x4*)(Lst + ((((size_t)item * 8 + w) * 8 + dt) * 64 + lane) * 4) = S[dt];
        if (pt == 0) {
#pragma unroll
            for (int e = 0; e < 8; ++e) DT[(size_t)item * HD + pd8 + e] = __expf(btot[e]);
        }
    }
}
__device__ __forceinline__ void phase_final(Frame& F) {
    const int gw = blockIdx.x * NWAVES + F.wave, NGW = F.G * NWAVES;
    const unsigned short* X = (const unsigned short*)(F.ws + WS_X); const float* ss = (const float*)(F.ws + WS_SS);
    v4u nx[4]; float ns = 0.f;
    if (gw < M) {
#pragma unroll
        for (int j = 0; j < 4; ++j) nx[j] = *((const GAS v4u*)(X + (size_t)gw * D) + F.lane + 64 * j);
        ns = (F.lane < 32) ? ss[(size_t)gw * 32 + F.lane] : 0.f; }
    for (int m = gw; m < M; m += NGW) {
        v4u cx[4];
#pragma unroll
        for (int j = 0; j < 4; ++j) cx[j] = nx[j];
        const float cs = ns; const int mn = m + NGW;
        if (mn < M) {
#pragma unroll
            for (int j = 0; j < 4; ++j) nx[j] = *((const GAS v4u*)(X + (size_t)mn * D) + F.lane + 64 * j);
            ns = (F.lane < 32) ? ss[(size_t)mn * 32 + F.lane] : 0.f; }
        const float rstd = rsqrtf(wave_sum(cs) * (1.0f / D) + EPS);
        GAS f32x4* orow = (GAS f32x4*)(F.out + (size_t)m * D) + 2 * F.lane; const GAS f32x4* gr = (const GAS f32x4*)F.fgain + 2 * F.lane;
#pragma unroll
        for (int j = 0; j < 4; ++j) { const f32x2_t p0 = unph2(cx[j].x), p1 = unph2(cx[j].y), p2 = unph2(cx[j].z), p3 = unph2(cx[j].w);
            orow[128 * j] = (f32x4){p0.x, p0.y, p1.x, p1.y} * rstd * gr[128 * j]; orow[128 * j + 1] = (f32x4){p2.x, p2.y, p3.x, p3.y} * rstd * gr[128 * j + 1]; }
    }
}

__device__ __forceinline__ float row_rstd(const float* ss, int row, int fq) {
    const f32x4 a = *(const GAS f32x4*)(ss + (size_t)row * 32 + fq * 8), b = *(const GAS f32x4*)(ss + (size_t)row * 32 + fq * 8 + 4);
    float s = ((a.x + a.y) + (a.z + a.w)) + ((b.x + b.y) + (b.z + b.w));
    s += __shfl_xor(s, 16); s += __shfl_xor(s, 32);
    return rsqrtf(s * (1.0f / D) + EPS);
}
template <bool XF32, bool WXG = true> struct EpiResid {
    static constexpr bool PERM = true;
    const void* xin; void* xr; bf16* xg; float* ss; const float* gate; const float* gnext;
    __device__ __forceinline__ void operator()(const pg8::f32x4 (&acc)[2][2][4][2], const pg8::Unit& u, int wr, int wc, int fr, int fq) const {
        const int b = u.pm >> 5, row0 = u.pm * 256 + wr * 64 + fr, col0 = u.pn * 256 + wc * 32 + 8 * fq;
        f32x4 gt[2][2], gn[2][2];
#pragma unroll
        for (int bj = 0; bj < 2; ++bj)
#pragma unroll
            for (int n = 0; n < 2; ++n) { gt[bj][n] = *(const GAS f32x4*)(gate + b * D + col0 + bj * 128 + 4 * n); gn[bj][n] = *(const GAS f32x4*)(gnext + b * D + col0 + bj * 128 + 4 * n); }
#pragma unroll
        for (int ai = 0; ai < 2; ++ai)
#pragma unroll
            for (int m = 0; m < 4; ++m) {
                const int row = row0 + ai * 128 + m * 16; const size_t ro = (size_t)row * D + col0; float sq = 0.f;
#pragma unroll
                for (int bj = 0; bj < 2; ++bj) {
                    f32x4 x0, x1;
                    if (XF32) { x0 = *(const GAS f32x4*)((const float*)xin + ro + bj * 128); x1 = *(const GAS f32x4*)((const float*)xin + ro + bj * 128 + 4); }
                    else { const v4u xb = *(const GAS v4u*)((const unsigned short*)xin + ro + bj * 128); const f32x2_t p0 = unph2(xb.x), p1 = unph2(xb.y), p2 = unph2(xb.z), p3 = unph2(xb.w);
                        x0 = (f32x4){p0.x, p0.y, p1.x, p1.y}; x1 = (f32x4){p2.x, p2.y, p3.x, p3.y}; }
                    const f32x4 v0 = x0 + gt[bj][0] * acc[ai][bj][m][0], v1 = x1 + gt[bj][1] * acc[ai][bj][m][1];
                    { v4u wx; wx.x = pkh2(v0.x, v0.y); wx.y = pkh2(v0.z, v0.w); wx.z = pkh2(v1.x, v1.y); wx.w = pkh2(v1.z, v1.w);
                        __builtin_nontemporal_store(wx, (GAS v4u*)((unsigned short*)xr + ro + bj * 128)); }
                    sq += (v0.x * v0.x + v0.y * v0.y) + (v0.z * v0.z + v0.w * v0.w) + (v1.x * v1.x + v1.y * v1.y) + (v1.z * v1.z + v1.w * v1.w);
                    if (WXG) { const f32x4 g0 = v0 * gn[bj][0], g1 = v1 * gn[bj][1];
                    v4u w; w.x = pg8::cvt_pk_bf16(g0.x, g0.y); w.y = pg8::cvt_pk_bf16(g0.z, g0.w); w.z = pg8::cvt_pk_bf16(g1.x, g1.y); w.w = pg8::cvt_pk_bf16(g1.z, g1.w);
                    *(GAS v4u*)(xg + ro + bj * 128) = w; }
                }
                sq += __shfl_xor(sq, 16); sq += __shfl_xor(sq, 32);
                if (fq == 0) ss[(size_t)row * 32 + u.pn * 4 + wc] = sq;
            }
    }
};
constexpr int RS_OFF = RING_BYTES + 1024;
__device__ __forceinline__ void phase_row_rstd(Frame& F, const float* ss, int pm) {
    if (F.tid < 256) { const float* p = ss + ((size_t)pm * 256 + F.tid) * 32; float s = 0.f;
#pragma unroll
        for (int q = 0; q < 8; ++q) { const f32x4 a = *(const GAS f32x4*)(p + 4 * q); s += (a.x + a.y) + (a.z + a.w); }
        ((LAS float*)(F.lds + RS_OFF))[F.tid] = rsqrtf(s * (1.0f / D) + EPS); }
    __syncthreads();
}
struct EpiSwiglu {
    static constexpr bool PERM = true;
    const LAS float* rs; const float* bias; bf16* hid;
    __device__ __forceinline__ void operator()(const pg8::f32x4 (&acc)[2][2][4][2], const pg8::Unit& u, int wr, int wc, int fr, int fq) const {
        const int b = u.pm >> 5, row0 = u.pm * 256 + wr * 64 + fr, cin = u.pn * 256 + wc * 32 + 8 * fq, cout = u.pn * 128 + wc * 32 + 8 * fq;
        f32x4 bs[2][2];
#pragma unroll
        for (int bj = 0; bj < 2; ++bj)
#pragma unroll
            for (int n = 0; n < 2; ++n) bs[bj][n] = *(const GAS f32x4*)(bias + (size_t)b * NFF2 + cin + bj * 128 + 4 * n);
#pragma unroll
        for (int ai = 0; ai < 2; ++ai)
#pragma unroll
            for (int m = 0; m < 4; ++m) {
                const int row = row0 + ai * 128 + m * 16; const float rstd = rs[ai * 128 + wr * 64 + m * 16 + fr];
                float hv[8];
#pragma unroll
                for (int n = 0; n < 2; ++n) { const f32x4 a = acc[ai][0][m][n] * rstd + bs[0][n], bb = acc[ai][1][m][n] * rstd + bs[1][n];
#pragma unroll
                    for (int e = 0; e < 4; ++e) hv[4 * n + e] = a[e] * sigmoidf_(a[e]) * bb[e]; }
                v4u w; w.x = pg8::cvt_pk_bf16(hv[0], hv[1]); w.y = pg8::cvt_pk_bf16(hv[2], hv[3]); w.z = pg8::cvt_pk_bf16(hv[4], hv[5]); w.w = pg8::cvt_pk_bf16(hv[6], hv[7]);
                *(GAS v4u*)(hid + (size_t)row * DFF + cout) = w;
            }
    }
};
struct EpiProj {
    static constexpr bool PERM = true;
    const LAS float* rs; const float* bias; const float* lb; bf16* out;
    template <int TYP> __device__ __forceinline__ void body(const pg8::f32x4 (&acc)[2][2][4][2], const pg8::Unit& u, int wr, int wc, int fr, int fq) const {
        const int b = u.pm >> 5, row0 = u.pm * 256 + wr * 64 + fr, cin = u.pn * 256 + wc * 32 + 8 * fq, cout = (u.pn & 7) * 256 + wc * 32 + 8 * fq;
        bf16* dst = out + (size_t)TYP * M * D;
        f32x4 bs[2][2], lbv[2][2];
#pragma unroll
        for (int bj = 0; bj < 2; ++bj)
#pragma unroll
            for (int n = 0; n < 2; ++n) { bs[bj][n] = *(const GAS f32x4*)(bias + (size_t)b * NPROJ + cin + bj * 128 + 4 * n); lbv[bj][n] = (TYP == 1) ? *(const GAS f32x4*)(lb + cout + bj * 128 + 4 * n) : (f32x4){0.f, 0.f, 0.f, 0.f}; }
#pragma unroll
        for (int ai = 0; ai < 2; ++ai)
#pragma unroll
            for (int m = 0; m < 4; ++m) {
                const int row = row0 + ai * 128 + m * 16; const float rstd = rs[ai * 128 + wr * 64 + m * 16 + fr];
#pragma unroll
                for (int bj = 0; bj < 2; ++bj) {
                    float r[8];
#pragma unroll
                    for (int n = 0; n < 2; ++n) { const f32x4 v = acc[ai][bj][m][n] * rstd + bs[bj][n];
#pragma unroll
                        for (int e = 0; e < 4; ++e) { float x = v[e];
                            if (TYP == 1) { const float lo = lbv[bj][n][e]; x = __logf(lo + (1.0f - lo) * sigmoidf_(x)); }
                            if (TYP == 3) x = x * sigmoidf_(x);
                            r[4 * n + e] = x; } }
                    v4u w; w.x = pg8::cvt_pk_bf16(r[0], r[1]); w.y = pg8::cvt_pk_bf16(r[2], r[3]); w.z = pg8::cvt_pk_bf16(r[4], r[5]); w.w = pg8::cvt_pk_bf16(r[6], r[7]);
                    *(GAS v4u*)(dst + (size_t)row * D + cout + bj * 128) = w;
                }
            }
    }
    __device__ __forceinline__ void operator()(const pg8::f32x4 (&acc)[2][2][4][2], const pg8::Unit& u, int wr, int wc, int fr, int fq) const {
        const int typ = u.pn >> 3;
        if (typ == 1) body<1>(acc, u, wr, wc, fr, fq); else if (typ == 3) body<3>(acc, u, wr, wc, fr, fq); else if (typ == 0) body<0>(acc, u, wr, wc, fr, fq); else body<2>(acc, u, wr, wc, fr, fq);
    }
};
struct EpiNull {
    static constexpr bool PERM = true;
    float* dummy;
    __device__ __forceinline__ void operator()(const pg8::f32x4 (&acc)[2][2][4][2], const pg8::Unit& u, int wr, int wc, int fr, int fq) const {
        f32x4 s = {0.f, 0.f, 0.f, 0.f};
#pragma unroll
        for (int ai = 0; ai < 2; ++ai)
#pragma unroll
            for (int bj = 0; bj < 2; ++bj)
#pragma unroll
                for (int m = 0; m < 4; ++m)
#pragma unroll
                    for (int n = 0; n < 2; ++n) s += acc[ai][bj][m][n];
        if (s.x + s.y + s.z + s.w == 12345.678f) dummy[(u.pm * 64 + u.pn) * 512 + threadIdx.x] = s.x;
    }
};
#ifndef MK_RX
#define MK_RX 0
#endif
#ifndef MK_XP
#define MK_XP 0
#endif
#ifndef MK_REPEAT_NULL
#define MK_REPEAT_NULL 0
#endif
#ifndef MK_REPEAT
#define MK_REPEAT -1
#endif
#ifndef MK_REPEAT_N
#define MK_REPEAT_N 1
#endif
#ifndef MK_NAIVE_REC
#define MK_NAIVE_REC 0
#endif
#ifndef MK_SP2
#define MK_SP2 true
#endif
#ifndef MK_ALIGN
#define MK_ALIGN true
#endif

struct Args { const float* in[15]; float* out; unsigned char* ws; int ph_lo, ph_hi; };
struct RowSplitOrder : pg8::StaticOrder {
    __device__ bool next(int i, pg8::Unit& u) const {
        if (G != 256 || nM != 64 || nN != 8) return pg8::StaticOrder::next(i, u);
        if (i >= 2) return false;
        const int x = c & 7, off = c >> 3; u.pm = 8 * x + 4 * i + (off & 3); u.pn = off >> 2; return true;
    }
};
template <int l> __device__ __forceinline__ void layer_phases(Frame& F, const Args& args, const XcdBarrier& bar, int lo, int hi) {
#define IN(k) (lo <= (k) && (k) < hi)
#define SEAM(k) do { if (IN(k) && IN((k) + 1)) xcd_barrier(bar, F.wave); } while (0)
#define RUNPH(k, ...) do { if (IN(k)) { F.lane = lane_id(); F.tid = F.wave * 64 + F.lane; if (MK_REPEAT == (k)) { _Pragma("unroll") for (int _r = 0; _r < MK_REPEAT_N; ++_r) { { __VA_ARGS__ } xcd_barrier(bar, F.wave); } } { __VA_ARGS__ } } } while (0)
    unsigned short* X = (unsigned short*)(args.ws + WS_X); bf16* XG = (bf16*)(args.ws + WS_XG); bf16* AOP = (bf16*)(args.ws + WS_AOP); bf16* HID = (bf16*)(args.ws + WS_HID); bf16* PROJ = (bf16*)(args.ws + WS_PROJ);
    float* SS = (float*)(args.ws + WS_SS);
    unsigned short* DX = (unsigned short*)(args.ws + WS_END); bf16* DXG = (bf16*)(args.ws + WS_END + 128 * MiB); float* DSS = (float*)(args.ws + WS_END + 192 * MiB);
    int rep_i = 0; (void)rep_i; (void)DX; (void)DXG; (void)DSS;
    constexpr int pb = 3 + (l >> 1) * 10 + (l & 1) * 4, j = l >> 1;
    constexpr bool pool = (l & 1) == 0;
    constexpr int pf = pool ? pb + 2 : pb + 4;
    const void* xsrc = (l == 0) ? (const void*)F.x : (const void*)X;
    if constexpr (pool) {
        if constexpr (l != 0) { RUNPH(pb, phase_poolprep<false>(F, l, xsrc);); SEAM(pb); }
    } else {
        RUNPH(pb,
            pg8::Gemm g{XG, (const bf16*)(args.ws + WS_WHIN) + (size_t)j * NPROJ * D, D, D, D, 0}; pg8::StaticOrder S; S.init(M, NPROJ, F.G, (int)blockIdx.x);
            { pg8::Unit u0; if (S.next(0, u0)) phase_row_rstd(F, SS, u0.pm); }
            EpiProj E{(const LAS float*)(F.lds + RS_OFF), F.vec + V_BIASP + (size_t)j * 2 * NPROJ, F.vec + V_LB + j * D, PROJ};
            pg8::gemm_phase<EpiProj, pg8::StaticOrder, MK_ALIGN, MK_SP2>(F.lds + RING_OFF, g, S, E, F.wave);
        ); SEAM(pb);
        RUNPH(pb + 1, phase_rec<false>(F, j);); SEAM(pb + 1);
        RUNPH(pb + 2, if (MK_RX != 0 && MK_REPEAT == pb + 2 && rep_i++ < MK_REPEAT_N) phase_rec<true, MK_RX>(F, j); else phase_rec<true>(F, j);); SEAM(pb + 2);
    }
    RUNPH(pf - 1,
        const bool dmy = (MK_REPEAT == pf - 1) && (rep_i++ < MK_REPEAT_N);
        pg8::Gemm g{AOP, pool ? (const bf16*)(args.ws + WS_WPOOL) + (size_t)j * 4 * PGD * PGD : (const bf16*)(args.ws + WS_WHOUT) + (size_t)j * D * D, D, pool ? PGD : D, pool ? PGD : D, pool ? PGD * 2 : 0};
        RowSplitOrder S; S.init(M, D, F.G, (int)blockIdx.x);
        EpiResid<l == 0> E{xsrc, dmy ? DX : X, dmy ? DXG : XG, dmy ? DSS : SS, F.vec + V_GATEM + l * 2 * D, F.vec + V_GF + l * 2 * D};
        pg8::gemm_phase<EpiResid<l == 0>, RowSplitOrder, MK_ALIGN, MK_SP2>(F.lds + RING_OFF, g, S, E, F.wave);
    ); SEAM(pf - 1);
    RUNPH(pf,
        pg8::Gemm g{XG, (const bf16*)(args.ws + WS_WFIN) + (size_t)l * NFF2 * D, D, D, D, 0}; pg8::StaticOrder S; S.init(M, NFF2, F.G, (int)blockIdx.x);
        { pg8::Unit u0; if (S.next(0, u0)) phase_row_rstd(F, SS, u0.pm); }
        if (MK_REPEAT_NULL && MK_REPEAT == pf && rep_i++ < MK_REPEAT_N) { EpiNull E0{DSS}; pg8::gemm_phase<EpiNull, pg8::StaticOrder, MK_ALIGN, MK_SP2, MK_XP>(F.lds + RING_OFF, g, S, E0, F.wave); }
        else {
        EpiSwiglu E{(const LAS float*)(F.lds + RS_OFF), F.vec + V_BIASF + (size_t)l * 2 * NFF2, HID};
        pg8::gemm_phase<EpiSwiglu, pg8::StaticOrder, MK_ALIGN, MK_SP2>(F.lds + RING_OFF, g, S, E, F.wave); }
    ); SEAM(pf);
    RUNPH(pf + 1,
        const bool dmy = (MK_REPEAT == pf + 1) && (rep_i++ < MK_REPEAT_N);
        pg8::Gemm g{HID, (const bf16*)(args.ws + WS_WFOUT) + (size_t)l * D * DFF, DFF, DFF, DFF, 0}; RowSplitOrder S; S.init(M, D, F.G, (int)blockIdx.x);
        EpiResid<false, pool> E{X, dmy ? DX : X, dmy ? DXG : XG, dmy ? DSS : SS, F.vec + V_GATEF + l * 2 * D, F.vec + V_GM + ((l + 1) & 3) * 2 * D};
        pg8::gemm_phase<EpiResid<false, pool>, RowSplitOrder, MK_ALIGN, MK_SP2>(F.lds + RING_OFF, g, S, E, F.wave);
    ); SEAM(pf + 1);
#undef RUNPH
#undef IN
#undef SEAM
}
__global__ void __launch_bounds__(NWAVES * 64, 2) mk_fwd(Args args) {
    extern __shared__ __attribute__((aligned(16))) unsigned char lds[];
    Frame F;
    F.lds = (LAS unsigned char*)lds;
    F.tid = threadIdx.x; F.lane = F.tid & 63; F.wave = __builtin_amdgcn_readfirstlane(F.tid >> 6); F.G = gridDim.x;
    F.x = args.in[0]; F.c = args.in[1]; F.gmix = args.in[2]; F.gffn = args.in[3]; F.wada = args.in[4]; F.bada = args.in[5]; F.poolw = args.in[6]; F.pools = args.in[7];
    F.hwin = args.in[8]; F.hwout = args.in[9]; F.hgain = args.in[10]; F.hlb = args.in[11]; F.wfin = args.in[12]; F.wfout = args.in[13]; F.fgain = args.in[14];
    F.out = args.out; F.ws = args.ws; F.vec = (float*)(args.ws + WS_VEC);
    volatile LAS unsigned* MISC = (volatile LAS unsigned*)(F.lds + MISC_OFF);
    for (int u = F.tid; u < (LDS_BYTES - LDSCTL_OFF) / 4; u += NWAVES * 64) ((LAS unsigned*)(F.lds + LDSCTL_OFF))[u] = 0u;
    __syncthreads();
    const int lo = args.ph_lo, hi = args.ph_hi;
    const bool multi = (hi - lo) > 1;
    XcdBarrier bar; bar.bar = (unsigned*)(args.ws + WS_CTL) + CW_BAR; bar.x = 0; bar.st = nullptr;
    if (multi) bar = xcd_barrier_post((unsigned*)(args.ws + WS_CTL) + CW_BAR, MISC + 8);
#define IN(k) (lo <= (k) && (k) < hi)
#define SEAM(k) do { if (IN(k) && IN((k) + 1)) xcd_barrier(bar, F.wave); } while (0)

#define RUNPH(k, ...) do { if (IN(k)) { F.lane = lane_id(); F.tid = F.wave * 64 + F.lane; if (MK_REPEAT == (k)) { _Pragma("unroll") for (int _r = 0; _r < MK_REPEAT_N; ++_r) { { __VA_ARGS__ } xcd_barrier(bar, F.wave); } } { __VA_ARGS__ } } } while (0)
    RUNPH(0, phase_p0a(F);); SEAM(0);
    RUNPH(1, phase_p0b(F);); SEAM(1);
    RUNPH(2, phase_p0c(F); __syncthreads(); phase_poolprep<true>(F, 0, (const void*)F.x);); SEAM(2);

    layer_phases<0>(F, args, bar, lo, hi); layer_phases<1>(F, args, bar, lo, hi); layer_phases<2>(F, args, bar, lo, hi); layer_phases<3>(F, args, bar, lo, hi);
    RUNPH(NPHASE - 1, phase_final(F););
#undef RUNPH
#undef IN
#undef SEAM
}

#ifndef MK_N_LAUNCHES
#define MK_N_LAUNCHES 1
#endif
extern "C" void kernel_launch(void* const* d_in, const int* in_sizes, int n_in, void* d_out, int out_size, void* d_ws, size_t ws_size, hipStream_t stream) {
    static int grid = 0;
    if (grid == 0) {
        if (n_in != 15 || in_sizes[0] != M * D || out_size != M * D || ws_size < WS_END) { fprintf(stderr, "kernel_launch: unexpected shapes (n_in %d in0 %d out %d ws %zu)\n", n_in, n_in > 0 ? in_sizes[0] : -1, out_size, ws_size); grid = -1; return; }
        int dev = 0, cus = 0, per_cu = 0;
        if (hipGetDevice(&dev) != hipSuccess || hipDeviceGetAttribute(&cus, hipDeviceAttributeMultiprocessorCount, dev) != hipSuccess) { grid = -1; return; }
        if (hipFuncSetAttribute((const void*)mk_fwd, hipFuncAttributeMaxDynamicSharedMemorySize, LDS_BYTES) != hipSuccess) { fprintf(stderr, "kernel_launch: hipFuncSetAttribute failed\n"); grid = -1; return; }
        if (hipOccupancyMaxActiveBlocksPerMultiprocessor(&per_cu, (const void*)mk_fwd, NWAVES * 64, LDS_BYTES) != hipSuccess || per_cu < 1) fprintf(stderr, "kernel_launch: occupancy query says %d\n", per_cu);
        (void)hipGetLastError();
        grid = cus;
    }
    if (grid < 0) return;
    if (hipMemsetAsync((char*)d_ws + WS_CTL, 0, CTL_ZERO_BYTES, stream) != hipSuccess) return;
    Args a{};
    for (int i = 0; i < 15; ++i) a.in[i] = (const float*)d_in[i];
    a.out = (float*)d_out; a.ws = (unsigned char*)d_ws;
    if (MK_N_LAUNCHES == 1) { a.ph_lo = 0; a.ph_hi = NPHASE; hipLaunchKernelGGL(mk_fwd, dim3(grid), dim3(NWAVES * 64), LDS_BYTES, stream, a); }
    else for (int p = 0; p < NPHASE; ++p) { a.ph_lo = p; a.ph_hi = p + 1; hipLaunchKernelGGL(mk_fwd, dim3(grid), dim3(NWAVES * 64), LDS_BYTES, stream, a); }
}
```

```cpp
#include <hip/hip_runtime.h>
#include <cstdio>
#include <cstdint>
namespace pg8 {
#define PG8_LAS __attribute__((address_space(3)))
typedef unsigned short bf16_t;
typedef short bf16x8 __attribute__((ext_vector_type(8)));
typedef float f32x4 __attribute__((ext_vector_type(4)));
typedef unsigned u32x4 __attribute__((ext_vector_type(4)));
constexpr int BM = 256, BK = 64, HALF = 128, HTB = HALF * BK * 2  , STAGE_BYTES = 8 * HTB, NXCD = 8, WGM = 8;

__host__ __device__ __forceinline__ int lds_byte(int r, int c) { const int st = (r >> 4) * 2 + (c >> 5), rr = r & 15, cc = c & 31, ob = rr * 64 + cc * 2; return st * 1024 + (ob ^ (((ob >> 9) & 1) << 5)); }
__host__ __device__ __forceinline__ void stage_rc(int b, int& R, int& C) { const int st = b / 1024, sb = b % 1024, swz = sb ^ (((sb >> 9) & 1) << 5); R = (st >> 1) * 16 + swz / 64; C = (st & 1) * 32 + (swz % 64) / 2; }
__host__ __device__ __forceinline__ int perm32(int rho) { const int n = rho >> 4, i = rho & 15; return 8 * (i >> 2) + 4 * n + (i & 3); }

struct Unit { int pm, pn; };
struct Gemm { const bf16_t* A; const bf16_t* Bt; int lda, ldb, K, agrp_bytes; };

struct StaticOrder {
    int nM, nN, nwg, G, c;
    __host__ __device__ void init(int M, int N, int G_, int c_) { nM = M / BM; nN = N / BM; nwg = nM * nN; G = G_; c = c_; }
    __host__ __device__ bool next(int i, Unit& u) const {
        const long L = (long)i * G + c; if (L >= nwg) return false;
        int wgid = (int)L; { const int q = nwg / NXCD, r = nwg % NXCD, xcd = wgid % NXCD, off = wgid / NXCD; wgid = (xcd < r ? xcd * (q + 1) : r * (q + 1) + (xcd - r) * q) + off; }
        const int nig = WGM * nN, gid = wgid / nig, fm = gid * WGM, gsz = (nM - fm) < WGM ? (nM - fm) : WGM;
        u.pm = fm + ((wgid % nig) % gsz); u.pn = (wgid % nig) / gsz; return true;
    }
    __device__ __forceinline__ void a_ready(const Unit&) const {}
    __device__ __forceinline__ void done(const Unit&) const {}
};

__device__ __forceinline__ unsigned cvt_pk_bf16(float lo, float hi) { typedef float f2_ __attribute__((ext_vector_type(2))); typedef __bf16 b2_ __attribute__((ext_vector_type(2))); const f2_ v = {lo, hi}; return __builtin_bit_cast(unsigned, __builtin_convertvector(v, b2_)); }

template <class Epi, class Sched, bool ALIGN_EPI = false, bool SP2 = false, int XP = 0  >
__device__ __forceinline__ void gemm_phase(PG8_LAS unsigned char* lds, const Gemm g, const Sched& S, const Epi& E, const int wid) {
    const int lane = __builtin_amdgcn_mbcnt_hi(~0u, __builtin_amdgcn_mbcnt_lo(~0u, 0u)), tid = wid * 64 + lane, wr = wid >> 2, wc = wid & 3, fr = lane & 15, fq = lane >> 4;
    const int K = g.K, nt = K / BK;
    unsigned voffA[2], voffB[2];
#pragma unroll
    for (int i = 0; i < 2; ++i) { int R, C; stage_rc(tid * 16 + i * 8192, R, C); const int Rb = Epi::PERM ? ((Epi::BJ32 ? 64 * (R >> 5) : (R & ~31)) + perm32(R & 31)) : R;
        voffA[i] = (unsigned)(R * g.lda + C) * 2u; voffB[i] = (unsigned)(Rb * g.ldb + C) * 2u; }
    const unsigned kstep = (unsigned)(BK * 2);
    const unsigned hstepA = (unsigned)HALF * g.lda * 2, hstepB = (unsigned)(Epi::BJ32 ? 32 : HALF) * g.ldb * 2;
    const unsigned tstepA = 2 * hstepA, tstepB = 2u * HALF * g.ldb * 2;
    const __amdgpu_buffer_rsrc_t rsA = __builtin_amdgcn_make_buffer_rsrc((void*)g.A, (short)0, 0x7ffffff0, 0x00020000), rsB = __builtin_amdgcn_make_buffer_rsrc((void*)g.Bt, (short)0, 0x7ffffff0, 0x00020000);
    const unsigned ldsw = (unsigned)wid * 1024u;
    const int aoff = lds_byte(wr * 64 + fr, fq * 8), boff = lds_byte(wc * 32 + fr, fq * 8);
#define PG8_SA(b, h) (((b) * 2 + (h)) * HTB)
#define PG8_SB(b, h) ((4 + (b) * 2 + (h)) * HTB)
#define PG8_STAGE_A(bufoff, soff, voff) do { if (!(XP & 4)) _Pragma("unroll") for (int _i = 0; _i < 2; ++_i) \
        __builtin_amdgcn_raw_ptr_buffer_load_lds(rsA, (PG8_LAS void*)(lds + (bufoff) + ldsw + _i * 8192), 16, (int)(voff)[_i], (int)(soff), 0, 0); } while (0)
#define PG8_STAGE_B(bufoff, soff, voff) do { if (!(XP & 4)) _Pragma("unroll") for (int _i = 0; _i < 2; ++_i) \
        __builtin_amdgcn_raw_ptr_buffer_load_lds(rsB, (PG8_LAS void*)(lds + (bufoff) + ldsw + _i * 8192), 16, (int)(voff)[_i], (int)(soff), 0, 0); } while (0)
#define PG8_LDA(dst, b, h) do { if (!(XP & 2)) _Pragma("unroll") for (int m = 0; m < 4; ++m) _Pragma("unroll") for (int k = 0; k < 2; ++k) dst[m][k] = *(const PG8_LAS bf16x8*)(lds + PG8_SA(b, h) + aoff + m * 2048 + k * 1024); } while (0)
#define PG8_LDB(dst, b, h) do { if (!(XP & 2)) _Pragma("unroll") for (int n = 0; n < 2; ++n) _Pragma("unroll") for (int k = 0; k < 2; ++k) dst[n][k] = *(const PG8_LAS bf16x8*)(lds + PG8_SB(b, h) + boff + n * 2048 + k * 1024); } while (0)
#define PG8_MMA(ai, bj, At, Bt) do { if (!(XP & 8)) __builtin_amdgcn_s_setprio(1); _Pragma("unroll") for (int m = 0; m < 4; ++m) _Pragma("unroll") for (int n = 0; n < 2; ++n) _Pragma("unroll") for (int k = 0; k < 2; ++k) { \
        if (!(XP & 1)) acc[ai][bj][m][n] = __builtin_amdgcn_mfma_f32_16x16x32_bf16(Bt[n][k], At[m][k], acc[ai][bj][m][n], 0, 0, 0); else asm volatile("" :: "v"(Bt[n][k]), "v"(At[m][k])); } if (!(XP & 8)) __builtin_amdgcn_s_setprio(0); } while (0)
#define PG8_WAIT_V(n) do { if (!(XP & 16)) asm volatile("s_waitcnt vmcnt(" #n ")" ::: "memory"); } while (0)
#define PG8_WAIT_L(n) asm volatile("s_waitcnt lgkmcnt(" #n ")" ::: "memory")
#define PG8_BAR __builtin_amdgcn_s_barrier()
#define PG8_SCHED __builtin_amdgcn_sched_barrier(0)
    Unit cur, nxt; int ui = 0;
    if (!S.next(0, cur)) return;
    f32x4 acc[2][2][4][2];
#pragma unroll
    for (int a = 0; a < 2; ++a)
#pragma unroll
        for (int b = 0; b < 2; ++b)
#pragma unroll
            for (int m = 0; m < 4; ++m)
#pragma unroll
                for (int n = 0; n < 2; ++n) acc[a][b][m][n] = (f32x4){0.f, 0.f, 0.f, 0.f};
    bf16x8 At[4][2], B0[2][2], B1[2][2];
    if (XP & 2) { bf16x8 pat; _Pragma("unroll") for (int q = 0; q < 8; ++q) pat[q] = (short)(0x3c00 + ((tid * 37 + q * 11) & 0x3ff));
        _Pragma("unroll") for (int m = 0; m < 4; ++m) _Pragma("unroll") for (int k = 0; k < 2; ++k) At[m][k] = pat;
        _Pragma("unroll") for (int n = 0; n < 2; ++n) _Pragma("unroll") for (int k = 0; k < 2; ++k) { B0[n][k] = pat; B1[n][k] = pat; } }
    unsigned cA = (unsigned)cur.pm * tstepA + (unsigned)(cur.pn >> 1) * g.agrp_bytes, cB = (unsigned)cur.pn * tstepB;
    S.a_ready(cur);
    if constexpr (SP2) {
        PG8_STAGE_B(PG8_SB(0, 0), cB, voffB); PG8_STAGE_B(PG8_SB(0, 1), cB + hstepB, voffB); PG8_STAGE_A(PG8_SA(0, 0), cA, voffA); PG8_STAGE_A(PG8_SA(0, 1), cA + hstepA, voffA);
        if (wr == 1) PG8_BAR;
        PG8_WAIT_V(2); PG8_BAR;
        PG8_STAGE_B(PG8_SB(1, 0), cB + kstep, voffB); PG8_STAGE_A(PG8_SA(1, 0), cA + kstep, voffA); PG8_STAGE_B(PG8_SB(1, 1), cB + hstepB + kstep, voffB);
        PG8_WAIT_V(6); PG8_BAR;
    } else {
        PG8_STAGE_B(PG8_SB(0, 0), cB, voffB); PG8_STAGE_A(PG8_SA(0, 0), cA, voffA); PG8_STAGE_B(PG8_SB(0, 1), cB + hstepB, voffB); PG8_STAGE_A(PG8_SA(0, 1), cA + hstepA, voffA);
        if (wr == 1) PG8_BAR;
        PG8_WAIT_V(4); PG8_BAR;
        PG8_STAGE_B(PG8_SB(1, 0), cB + kstep, voffB); PG8_STAGE_A(PG8_SA(1, 0), cA + kstep, voffA); PG8_STAGE_B(PG8_SB(1, 1), cB + hstepB + kstep, voffB);
        PG8_WAIT_V(6); PG8_BAR;
    }
    for (;;) {
        const bool has_next = S.next(ui + 1, nxt);
        const unsigned nA = has_next ? (unsigned)nxt.pm * tstepA + (unsigned)(nxt.pn >> 1) * g.agrp_bytes : cA, nB = has_next ? (unsigned)nxt.pn * tstepB : cB;
        for (int t = 0; t < nt; t += 2) {
            const bool last = (t == nt - 2);
            const unsigned a1 = cA + (unsigned)(t + 1) * kstep;
            const unsigned a2 = last ? nA : cA + (unsigned)(t + 2) * kstep, b2 = last ? nB : cB + (unsigned)(t + 2) * kstep;
            const unsigned a3 = a2 + kstep, b3 = b2 + kstep;
            if (last && has_next) S.a_ready(nxt);
            if constexpr (SP2) {
            PG8_LDB(B0, 0, 0); PG8_LDB(B1, 0, 1); PG8_SCHED; PG8_LDA(At, 0, 0); PG8_STAGE_A(PG8_SA(1, 1), a1 + hstepA, voffA);
            PG8_WAIT_V(8); PG8_WAIT_L(0); PG8_BAR; PG8_MMA(0, 0, At, B0); PG8_MMA(0, 1, At, B1); PG8_BAR; PG8_SCHED;
            PG8_LDA(At, 0, 1); PG8_STAGE_B(PG8_SB(0, 0), b2, voffB); PG8_STAGE_B(PG8_SB(0, 1), b2 + hstepB, voffB); PG8_STAGE_A(PG8_SA(0, 0), a2, voffA);
            PG8_WAIT_V(8); PG8_WAIT_L(0); PG8_BAR; PG8_MMA(1, 0, At, B0); PG8_MMA(1, 1, At, B1); PG8_BAR; PG8_SCHED;
            PG8_LDB(B0, 1, 0); PG8_LDB(B1, 1, 1); PG8_SCHED; PG8_LDA(At, 1, 0); PG8_STAGE_A(PG8_SA(0, 1), a2 + hstepA, voffA);
            PG8_WAIT_V(8); PG8_WAIT_L(0); PG8_BAR; PG8_MMA(0, 0, At, B0); PG8_MMA(0, 1, At, B1); PG8_BAR; PG8_SCHED;
            PG8_LDA(At, 1, 1); PG8_STAGE_B(PG8_SB(1, 0), b3, voffB); PG8_STAGE_B(PG8_SB(1, 1), b3 + hstepB, voffB); PG8_STAGE_A(PG8_SA(1, 0), a3, voffA);
            PG8_WAIT_V(8); PG8_WAIT_L(0); PG8_BAR; PG8_MMA(1, 0, At, B0); PG8_MMA(1, 1, At, B1); PG8_BAR; PG8_SCHED;
            } else {
            PG8_LDB(B0, 0, 0); PG8_SCHED; PG8_LDA(At, 0, 0); PG8_STAGE_A(PG8_SA(1, 1), a1 + hstepA, voffA);
            PG8_WAIT_L(8); PG8_BAR; PG8_WAIT_L(0); PG8_MMA(0, 0, At, B0); PG8_BAR; PG8_SCHED;
            PG8_LDB(B1, 0, 1); PG8_STAGE_B(PG8_SB(0, 0), b2, voffB);
            PG8_BAR; PG8_WAIT_L(0); PG8_MMA(0, 1, At, B1); PG8_BAR;
            PG8_LDA(At, 0, 1); PG8_STAGE_A(PG8_SA(0, 0), a2, voffA);
            PG8_BAR; PG8_WAIT_L(0); PG8_MMA(1, 0, At, B0); PG8_BAR; PG8_SCHED;
            PG8_STAGE_B(PG8_SB(0, 1), b2 + hstepB, voffB);
            PG8_WAIT_V(6); PG8_BAR; PG8_MMA(1, 1, At, B1); PG8_BAR;
            PG8_LDB(B0, 1, 0); PG8_SCHED; PG8_LDA(At, 1, 0); PG8_STAGE_A(PG8_SA(0, 1), a2 + hstepA, voffA);
            PG8_WAIT_L(8); PG8_BAR; PG8_WAIT_L(0); PG8_MMA(0, 0, At, B0); PG8_BAR; PG8_SCHED;
            PG8_LDB(B1, 1, 1); PG8_STAGE_B(PG8_SB(1, 0), b3, voffB);
            PG8_BAR; PG8_WAIT_L(0); PG8_MMA(0, 1, At, B1); PG8_BAR;
            PG8_LDA(At, 1, 1); PG8_STAGE_A(PG8_SA(1, 0), a3, voffA);
            PG8_BAR; PG8_WAIT_L(0); PG8_MMA(1, 0, At, B0); PG8_BAR; PG8_SCHED;
            PG8_STAGE_B(PG8_SB(1, 1), b3 + hstepB, voffB);
            PG8_WAIT_V(6); PG8_BAR; PG8_MMA(1, 1, At, B1); PG8_BAR;
            }
        }
        if constexpr (ALIGN_EPI) { if (wr == 0) PG8_BAR; }
        E(acc, cur, wr, wc, fr, fq); S.done(cur);
        if (!has_next) break;
#pragma unroll
        for (int a = 0; a < 2; ++a)
#pragma unroll
            for (int b = 0; b < 2; ++b)
#pragma unroll
                for (int m = 0; m < 4; ++m)
#pragma unroll
                    for (int n = 0; n < 2; ++n) acc[a][b][m][n] = (f32x4){0.f, 0.f, 0.f, 0.f};
        cur = nxt; cA = nA; cB = nB; ++ui;
        if constexpr (ALIGN_EPI) { if (wr == 1) PG8_BAR; }
    }
    PG8_WAIT_V(0);
    if constexpr (!ALIGN_EPI) { if (wr == 0) PG8_BAR; }
    PG8_BAR;
#undef PG8_SA
#undef PG8_SB
#undef PG8_STAGE_A
#undef PG8_STAGE_B
#undef PG8_LDA
#undef PG8_LDB
#undef PG8_MMA
#undef PG8_WAIT_V
#undef PG8_WAIT_L
#undef PG8_BAR
#undef PG8_SCHED
}
}
#ifndef MK_SEGLEN
#define MK_SEGLEN 1024
#endif
constexpr int NWAVES = 8;
constexpr int BATCH = 2, SEQ = 8192, D = 2048, M = BATCH * SEQ, DFF = 5632, NFF2 = 2 * DFF, NPROJ = 4 * D, NMOD = 6 * D, DEPTH = 4;
constexpr int HEADS = 16, HD = 128, PGD = 512;
constexpr float EPS = 1e-6f;
constexpr int KC = 32, KR = D / KC;
constexpr int NPHASE = 24;

constexpr size_t MiB = 1u << 20;
constexpr size_t WS_CTL = 0, CTL_ZERO_BYTES = 1 * MiB;
constexpr size_t WS_PART = 1 * MiB;
constexpr size_t WS_VEC = 14 * MiB;
constexpr size_t WS_SS = 16 * MiB;
constexpr size_t WS_REC = 18 * MiB;
constexpr size_t WS_WPOOL = 36 * MiB, WS_WHOUT = 40 * MiB, WS_WHIN = 56 * MiB, WS_WFIN = 120 * MiB, WS_WFOUT = 296 * MiB;
constexpr size_t WS_X = 384 * MiB, WS_XG = 512 * MiB, WS_AOP = 576 * MiB, WS_HID = 640 * MiB, WS_PROJ = 816 * MiB, WS_END = 1072 * MiB;
constexpr int V_SHM = 0, V_SHF = V_SHM + DEPTH * 2 * D, V_GM = V_SHF + DEPTH * 2 * D, V_GF = V_GM + DEPTH * 2 * D, V_GATEM = V_GF + DEPTH * 2 * D, V_GATEF = V_GATEM + DEPTH * 2 * D,
              V_LB = V_GATEF + DEPTH * 2 * D, V_BIASP = V_LB + 2 * D, V_BIASF = V_BIASP + 2 * 2 * NPROJ, V_END = V_BIASF + DEPTH * 2 * NFF2;
static_assert((size_t)V_END * 4 <= 2 * MiB, "vec region");
constexpr int CW_TMO = 0, CW_BAR = 4096;

constexpr int RING_OFF = 0, RING_BYTES = 131072;
constexpr int LDSCTL_OFF = RING_BYTES, MISC_OFF = LDSCTL_OFF + 320;
constexpr int LDS_BYTES = 147456;

#define GAS __attribute__((address_space(1)))
#define LAS __attribute__((address_space(3)))
typedef unsigned short bf16;
typedef unsigned v4u __attribute__((ext_vector_type(4)));
typedef unsigned v2u __attribute__((ext_vector_type(2)));
typedef float f32x4 __attribute__((ext_vector_type(4)));
typedef GAS unsigned gu32;
#define RLX_AGENT __ATOMIC_RELAXED, __HIP_MEMORY_SCOPE_AGENT
#define LDS_WAIT() asm volatile("s_waitcnt lgkmcnt(0)" ::: "memory")
#define VM_WAIT() asm volatile("s_waitcnt vmcnt(0)" ::: "memory")
__device__ __forceinline__ unsigned f2bf(float f) { unsigned u = __builtin_bit_cast(unsigned, f); return (u + 0x7fffu + ((u >> 16) & 1u)) >> 16; }
__device__ __forceinline__ unsigned pk2(float lo, float hi) { return f2bf(lo) | (f2bf(hi) << 16); }
__device__ __forceinline__ float bf2f(unsigned short b) { return __builtin_bit_cast(float, (unsigned)b << 16); }
__device__ __forceinline__ float bflo(unsigned w) { return __builtin_bit_cast(float, w << 16); }
__device__ __forceinline__ float bfhi(unsigned w) { return __builtin_bit_cast(float, w & 0xffff0000u); }
typedef _Float16 h2_t __attribute__((ext_vector_type(2)));
typedef float f32x2_t __attribute__((ext_vector_type(2)));
__device__ __forceinline__ unsigned pkh2(float lo, float hi) { const f32x2_t v = {lo, hi}; return __builtin_bit_cast(unsigned, __builtin_convertvector(v, h2_t)); }
__device__ __forceinline__ f32x2_t unph2(unsigned w) { return __builtin_convertvector(__builtin_bit_cast(h2_t, w), f32x2_t); }
__device__ __forceinline__ float sigmoidf_(float v) { return __builtin_amdgcn_rcpf(1.0f + __expf(-v)); }

#define XB_TMO      128
#define XB_XCNT(j)  (256  + 64 * (j))
#define XB_XSUB(j)  (1280 + 64 * (j))
#define XB_XGEN(j)  (2304 + 64 * (j))
#define XB_TOP      3328
#define XB_TOPGEN   3392
#define XCD_BAR_WORDS 3456
#define XB_SPIN_CAP (1u << 18)

__device__ __forceinline__ unsigned xb_ld(unsigned* p)              { return __hip_atomic_load(p, __ATOMIC_RELAXED, __HIP_MEMORY_SCOPE_AGENT); }
__device__ __forceinline__ unsigned xb_add(unsigned* p, unsigned v) { return __hip_atomic_fetch_add(p, v, __ATOMIC_RELAXED, __HIP_MEMORY_SCOPE_AGENT); }
__device__ __forceinline__ unsigned xb_xcc_id() { return (unsigned)__builtin_amdgcn_s_getreg((3 << 11) | 20) & 0xFu; }
#define XB_SPIN(cond, bar) do { unsigned _sp = 0; while (cond) { __builtin_amdgcn_s_sleep(1); \
    if ((++_sp & 255u) == 0u) { if (xb_ld(&(bar)[XB_TMO])) break; if (_sp > XB_SPIN_CAP) { atomicAdd(&(bar)[XB_TMO], 1u); break; } } } } while (0)

struct XcdBarrier { unsigned* bar; unsigned x; volatile LAS unsigned* st; };

__device__ __forceinline__ XcdBarrier xcd_barrier_post(unsigned* bar, volatile LAS unsigned* st) {
    XcdBarrier b; b.bar = bar; b.x = xb_xcc_id(); b.st = st;
    if (threadIdx.x == 0) (void)xb_add(&bar[XB_XCNT(b.x)], 1u);
    return b;
}
__device__ __forceinline__ void xcd_barrier_complete(unsigned* bar, unsigned x, unsigned& nloc, unsigned& nx) {
    const unsigned G = gridDim.x * gridDim.y * gridDim.z;
    unsigned sum, cnt, mine, sp = 0u;
    for (;;) {
        sum = 0u; cnt = 0u; mine = 0u;
#pragma unroll
        for (unsigned j = 0; j < 16; ++j) { const unsigned c = xb_ld(&bar[XB_XCNT(j)]); sum += c; cnt += (c > 0u) ? 1u : 0u; mine = (j == x) ? c : mine; }
        if (sum == G) break;
        __builtin_amdgcn_s_sleep(1);
        if ((++sp & 255u) == 0u) { if (xb_ld(&bar[XB_TMO])) break; if (sp > XB_SPIN_CAP) { atomicAdd(&bar[XB_TMO], 1u); break; } }
    }
    nloc = mine > 0u ? mine : 1u; nx = cnt > 0u ? cnt : 1u;
}
__device__ __forceinline__ void xcd_barrier(const XcdBarrier& b, const int wave) {
    asm volatile("s_waitcnt vmcnt(0)" ::: "memory");
    __syncthreads();
    if (wave == 0 && __builtin_amdgcn_mbcnt_hi(~0u, __builtin_amdgcn_mbcnt_lo(~0u, 0u)) == 0) {
        unsigned* bar = b.bar;
        __builtin_amdgcn_s_waitcnt(0);
        unsigned nloc = b.st[0], nx = b.st[1];
        if (nloc == 0u) { xcd_barrier_complete(bar, b.x, nloc, nx); b.st[0] = nloc; b.st[1] = nx; }
        const unsigned old = xb_add(&bar[XB_XSUB(b.x)], 1u);
        const unsigned gen = old / nloc;
        if (old + 1u == (gen + 1u) * nloc) {
            __builtin_amdgcn_fence(__ATOMIC_RELEASE, "agent");
            asm volatile("s_waitcnt vmcnt(0)" ::: "memory");
            const unsigned og = xb_add(&bar[XB_TOP], 1u);
            const unsigned tg = og / nx;
            if (og + 1u == (tg + 1u) * nx) xb_add(&bar[XB_TOPGEN], 1u);
            else XB_SPIN(xb_ld(&bar[XB_TOPGEN]) == tg, bar);
            __builtin_amdgcn_fence(__ATOMIC_ACQUIRE, "agent");
            xb_add(&bar[XB_XGEN(b.x)], 1u);
            asm volatile("s_waitcnt vmcnt(0)" ::: "memory");
        } else {
            XB_SPIN(xb_ld(&bar[XB_XGEN(b.x)]) == gen, bar);
            __builtin_amdgcn_fence(__ATOMIC_ACQUIRE, "agent");
            asm volatile("s_waitcnt vmcnt(0)" ::: "memory");
        }
    }
    __syncthreads();
}

struct Frame {
    LAS unsigned char* lds;
    int tid, lane, wave, G;
    const float *x, *c, *gmix, *gffn, *wada, *bada, *poolw, *pools, *hwin, *hwout, *hgain, *hlb, *wfin, *wfout, *fgain;
    float* out; unsigned char* ws;
    float* vec;
};
__device__ __forceinline__ int lane_id() { int l = __builtin_amdgcn_mbcnt_hi(~0u, __builtin_amdgcn_mbcnt_lo(~0u, 0u)); asm volatile("" : "+v"(l)); return l; }
__device__ __forceinline__ float wave_sum(float v) {
#pragma unroll
    for (int o = 1; o < 64; o <<= 1) v += __shfl_xor(v, o);
    return v;
}

struct CvtTile { f32x4 w[8]; };
__device__ __forceinline__ void cvt_load(CvtTile& t, const float* W, int N, int k0, int n0_src, int lane) {
#pragma unroll
    for (int i = 0; i < 8; ++i) t.w[i] = *(const GAS f32x4*)(W + (size_t)(k0 + 8 * i + (lane >> 3)) * N + n0_src + 4 * (lane & 7));
}
template <bool BIAS>
__device__ __forceinline__ void cvt_store(const CvtTile& t, bf16* WT, int K, int k0, int n0_dst, LAS float* scr, int lane, const LAS float* shL, int Ktot, float (&bacc)[2][4]) {
#pragma unroll
    for (int i = 0; i < 8; ++i) { LAS float* p = scr + (8 * i + (lane >> 3)) * 33 + 4 * (lane & 7); p[0] = t.w[i].x; p[1] = t.w[i].y; p[2] = t.w[i].z; p[3] = t.w[i].w; }
    LDS_WAIT(); asm volatile("" ::: "memory");
    const int c = lane & 7;
    f32x4 s0a, s0b, s1a, s1b;
    if (BIAS) { s0a = *(const LAS f32x4*)(shL + k0 + 8 * c); s0b = *(const LAS f32x4*)(shL + k0 + 8 * c + 4); s1a = *(const LAS f32x4*)(shL + Ktot + k0 + 8 * c); s1b = *(const LAS f32x4*)(shL + Ktot + k0 + 8 * c + 4); }
#pragma unroll
    for (int j = 0; j < 4; ++j) { const int n = (lane >> 3) + 8 * j; const LAS float* s = scr + (8 * c) * 33 + n;
        const float v0 = s[0 * 33], v1 = s[1 * 33], v2 = s[2 * 33], v3 = s[3 * 33], v4 = s[4 * 33], v5 = s[5 * 33], v6 = s[6 * 33], v7 = s[7 * 33];
        if (BIAS) { bacc[0][j] += (v0 * s0a.x + v1 * s0a.y) + (v2 * s0a.z + v3 * s0a.w) + (v4 * s0b.x + v5 * s0b.y) + (v6 * s0b.z + v7 * s0b.w);
                    bacc[1][j] += (v0 * s1a.x + v1 * s1a.y) + (v2 * s1a.z + v3 * s1a.w) + (v4 * s1b.x + v5 * s1b.y) + (v6 * s1b.z + v7 * s1b.w); }
        v4u o; o.x = pg8::cvt_pk_bf16(v0, v1); o.y = pg8::cvt_pk_bf16(v2, v3); o.z = pg8::cvt_pk_bf16(v4, v5); o.w = pg8::cvt_pk_bf16(v6, v7);
        *(GAS v4u*)(WT + (size_t)(n0_dst + n) * K + k0 + 8 * c) = o; }
    LDS_WAIT(); asm volatile("" ::: "memory");
}
__device__ __forceinline__ void convert_matrix(Frame& F, const float* W, int K, int N, bf16* WT, LAS float* scr, int& itbase) {
    const int gw = blockIdx.x * NWAVES + F.wave, NGW = F.G * NWAVES;
    const int nblk = N / 32, nitems = (K / 64) * nblk;
    int it = (gw - itbase % NGW + NGW) % NGW;
    float dummy[2][4];
    CvtTile cur, nxt;
    if (it < nitems) cvt_load(nxt, W, N, 64 * (it / nblk), 32 * (it % nblk), F.lane);
    for (; it < nitems; it += NGW) {
        cur = nxt; const int itn = it + NGW;
        if (itn < nitems) cvt_load(nxt, W, N, 64 * (itn / nblk), 32 * (itn % nblk), F.lane);
        cvt_store<false>(cur, WT, K, 64 * (it / nblk), 32 * (it % nblk), scr, F.lane, nullptr, 0, dummy);
    }
    itbase += nitems;
}

__device__ __forceinline__ void phase_p0a(Frame& F) {
    const int gw = blockIdx.x * NWAVES + F.wave, NGW = F.G * NWAVES, gt = blockIdx.x * (NWAVES * 64) + F.tid;
    LAS float* condL = (LAS float*)(F.lds + RING_OFF);
    for (int i = F.tid; i < 2 * D; i += NWAVES * 64) { const float cv = F.c[i]; condL[i] = cv * sigmoidf_(cv); }
    __syncthreads();
    float* part = (float*)(F.ws + WS_PART);
    for (int it = gw; it < DEPTH * KC * (NMOD / 256); it += NGW) {
        const int ns = it % (NMOD / 256), kc = (it / (NMOD / 256)) % KC, l = it / ((NMOD / 256) * KC);
        const float* W = F.wada + ((size_t)l * D + (size_t)kc * KR) * NMOD + ns * 256 + F.lane * 4;
        f32x4 a0 = {0.f, 0.f, 0.f, 0.f}, a1 = {0.f, 0.f, 0.f, 0.f};
        for (int k = 0; k < KR; k += 8) {
            f32x4 w[8];
#pragma unroll
            for (int j = 0; j < 8; ++j) w[j] = *(const GAS f32x4*)(W + (size_t)(k + j) * NMOD);
#pragma unroll
            for (int j = 0; j < 8; ++j) { const float c0 = condL[kc * KR + k + j], c1 = condL[D + kc * KR + k + j]; a0 += c0 * w[j]; a1 += c1 * w[j]; }
        }
        *(GAS f32x4*)(part + ((size_t)(kc * DEPTH + l) * 2 + 0) * NMOD + ns * 256 + F.lane * 4) = a0;
        *(GAS f32x4*)(part + ((size_t)(kc * DEPTH + l) * 2 + 1) * NMOD + ns * 256 + F.lane * 4) = a1;
    }
    if (gt < D) {
        const float l0 = F.hlb[gt], l1 = F.hlb[D + gt], l2 = F.hlb[2 * D + gt], l3 = F.hlb[3 * D + gt];
        const float mx = fmaxf(fmaxf(l0, l1), fmaxf(l2, l3));
        const float e0 = __expf(l0 - mx), e1 = __expf(l1 - mx), e2 = __expf(l2 - mx), e3 = __expf(l3 - mx), inv = 1.0f / (e0 + e1 + e2 + e3);
        F.vec[V_LB + gt] = e1 * inv; F.vec[V_LB + D + gt] = (e1 + e2 + e3) * inv;
    }
    float* ss = (float*)(F.ws + WS_SS);
    for (int m = gw; m < M; m += NGW) {
        const GAS f32x4* xr = (const GAS f32x4*)(F.x + (size_t)m * D) + F.lane; float s = 0.f;
#pragma unroll
        for (int j = 0; j < 8; ++j) { const f32x4 v = xr[64 * j]; s += (v.x * v.x + v.y * v.y) + (v.z * v.z + v.w * v.w); }
        s = wave_sum(s);
        if (F.lane < 32) ss[(size_t)m * 32 + F.lane] = (F.lane == 0) ? s : 0.f;
    }
    __syncthreads();
    LAS float* scr = (LAS float*)(F.lds + RING_OFF + F.wave * 16384);
    int itbase = 0;
    for (int j = 0; j < 8; ++j) convert_matrix(F, F.poolw + (size_t)j * PGD * PGD, PGD, PGD, (bf16*)(F.ws + WS_WPOOL) + (size_t)j * PGD * PGD, scr, itbase);
    for (int j = 0; j < 2; ++j) convert_matrix(F, F.hwout + (size_t)j * D * D, D, D, (bf16*)(F.ws + WS_WHOUT) + (size_t)j * D * D, scr, itbase);
    for (int j = 0; j < DEPTH; ++j) convert_matrix(F, F.wfout + (size_t)j * DFF * D, DFF, D, (bf16*)(F.ws + WS_WFOUT) + (size_t)j * DFF * D, scr, itbase);
}
__device__ __forceinline__ void phase_p0b(Frame& F) {
    const int gt = blockIdx.x * (NWAVES * 64) + F.tid;
    if (gt >= DEPTH * 2 * (D / 4) * 6) return;
    const int cq = gt % (D / 4), r = gt / (D / 4), j = r % 6, b = (r / 6) % 2, l = r / 12, col = cq * 4;
    const float* part = (const float*)(F.ws + WS_PART);
    f32x4 s = *(const GAS f32x4*)(F.bada + (size_t)l * NMOD + j * D + col);
    f32x4 pv[KC];
#pragma unroll
    for (int kc = 0; kc < KC; ++kc) pv[kc] = *(const GAS f32x4*)(part + ((size_t)(kc * DEPTH + l) * 2 + b) * NMOD + j * D + col);
#pragma unroll
    for (int kc = 0; kc < KC; ++kc) s += pv[kc];
    const int vo = (l * 2 + b) * D + col;
    if (j == 0) *(GAS f32x4*)(F.vec + V_SHM + vo) = s;
    else if (j == 1) *(GAS f32x4*)(F.vec + V_GM + vo) = *(const GAS f32x4*)(F.gmix + (size_t)l * D + col) * (1.0f + s);
    else if (j == 2) { if ((l & 1) == 0) s = s * *(const GAS f32x4*)(F.pools + (size_t)(l >> 1) * D + col); *(GAS f32x4*)(F.vec + V_GATEM + vo) = s; }
    else if (j == 3) *(GAS f32x4*)(F.vec + V_SHF + vo) = s;
    else if (j == 4) *(GAS f32x4*)(F.vec + V_GF + vo) = *(const GAS f32x4*)(F.gffn + (size_t)l * D + col) * (1.0f + s);
    else *(GAS f32x4*)(F.vec + V_GATEF + vo) = s;
}
__device__ __forceinline__ void phase_p0c(Frame& F) {
    constexpr int NB_H = NPROJ / 256, NB_F = NFF2 / 256;
    constexpr int NITEMS = 2 * NB_H + DEPTH * NB_F;
    LAS float* shL = (LAS float*)(F.lds + RING_OFF);
    LAS float* scr = (LAS float*)(F.lds + RING_OFF + 16384 + F.wave * 12288);
    for (int bi = blockIdx.x; bi < NITEMS; bi += F.G) {
        const bool is_h = bi < 2 * NB_H;
        const int mi = is_h ? bi / NB_H : (bi - 2 * NB_H) / NB_F, grp = is_h ? bi % NB_H : (bi - 2 * NB_H) % NB_F;
        const int layer = is_h ? 2 * mi + 1 : mi;
        const int N = is_h ? NPROJ : NFF2;
        const float* W = is_h ? F.hwin + (size_t)mi * D * NPROJ : F.wfin + (size_t)mi * D * NFF2;
        bf16* WT = is_h ? (bf16*)(F.ws + WS_WHIN) + (size_t)mi * NPROJ * D : (bf16*)(F.ws + WS_WFIN) + (size_t)mi * NFF2 * D;
        const float* shv = F.vec + (is_h ? V_SHM : V_SHF) + (size_t)layer * 2 * D;
        float* biasv = F.vec + (is_h ? V_BIASP + (size_t)mi * 2 * NPROJ : V_BIASF + (size_t)mi * 2 * NFF2);
        __syncthreads();
        for (int i = F.tid; i < 2 * D; i += NWAVES * 64) shL[i] = shv[i];
        __syncthreads();
        const int n0_dst = grp * 256 + F.wave * 32;
        int n0_src = n0_dst;
        if (!is_h) { const int pn = n0_dst / 256, within = n0_dst % 256, bj = within / 128, j = within % 128; n0_src = bj * DFF + pn * 128 + j; }
        float bacc[2][4];
#pragma unroll
        for (int q = 0; q < 2; ++q)
#pragma unroll
            for (int jj = 0; jj < 4; ++jj) bacc[q][jj] = 0.f;
        CvtTile cur, nxt, nx2;
        cvt_load(nxt, W, N, 0, n0_src, F.lane); cvt_load(nx2, W, N, 64, n0_src, F.lane);
        for (int kb = 0; kb < D / 64; ++kb) {
            cur = nxt; nxt = nx2;
            if (kb + 2 < D / 64) cvt_load(nx2, W, N, 64 * (kb + 2), n0_src, F.lane);
            cvt_store<true>(cur, WT, D, 64 * kb, n0_dst, scr, F.lane, shL, D, bacc);
        }
#pragma unroll
        for (int q = 0; q < 2; ++q)
#pragma unroll
            for (int jj = 0; jj < 4; ++jj) { float v = bacc[q][jj]; v += __shfl_xor(v, 1); v += __shfl_xor(v, 2); v += __shfl_xor(v, 4);
                if ((F.lane & 7) == 0) biasv[q * N + n0_dst + (F.lane >> 3) + 8 * jj] = v; }
    }
}
template <bool XF32>
__device__ __forceinline__ void load_x8(const void* xsrc, size_t eoff, float (&v)[8]) {
    if (XF32) { const f32x4 a = *(const GAS f32x4*)((const float*)xsrc + eoff), b = *(const GAS f32x4*)((const float*)xsrc + eoff + 4);
        v[0] = a.x; v[1] = a.y; v[2] = a.z; v[3] = a.w; v[4] = b.x; v[5] = b.y; v[6] = b.z; v[7] = b.w; }
    else { const v4u a = *(const GAS v4u*)((const unsigned short*)xsrc + eoff); const f32x2_t p0 = unph2(a.x), p1 = unph2(a.y), p2 = unph2(a.z), p3 = unph2(a.w);
        v[0] = p0.x; v[1] = p0.y; v[2] = p1.x; v[3] = p1.y; v[4] = p2.x; v[5] = p2.y; v[6] = p3.x; v[7] = p3.y; }
}
template <bool XF32>
__device__ __forceinline__ void phase_poolprep(Frame& F, int layer, const void* xsrc) {
    LAS float* rs = (LAS float*)(F.lds + RING_OFF);
    const float* ss = (const float*)(F.ws + WS_SS);
    bf16* dst = (bf16*)(F.ws + WS_AOP);
    for (int ts = blockIdx.x; ts < M / 64; ts += F.G) {
        const int r0 = ts * 64, b = r0 / SEQ, t0 = r0 % SEQ;
        __syncthreads();
        if (F.tid < 80) { const int row = r0 - 16 + F.tid; float v = 0.f;
            if (t0 - 16 + F.tid >= 0) { float s = 0.f; for (int j = 0; j < 32; ++j) s += ss[(size_t)row * 32 + j]; v = rsqrtf(s * (1.0f / D) + EPS); }
            rs[F.tid] = v; }
        __syncthreads();
        const int half = F.tid >> 8, col = (F.tid & 255) * 8, g = col >> 9, w = 2 << g, rb = r0 + half * 32, tb = t0 + half * 32, ib = 16 + half * 32;
        float gm[8], sh[8], S[8], xv[8];
        { const f32x4 a = *(const GAS f32x4*)(F.vec + V_GM + (layer * 2 + b) * D + col), c = *(const GAS f32x4*)(F.vec + V_GM + (layer * 2 + b) * D + col + 4);
          gm[0] = a.x; gm[1] = a.y; gm[2] = a.z; gm[3] = a.w; gm[4] = c.x; gm[5] = c.y; gm[6] = c.z; gm[7] = c.w; }
        { const f32x4 a = *(const GAS f32x4*)(F.vec + V_SHM + (layer * 2 + b) * D + col), c = *(const GAS f32x4*)(F.vec + V_SHM + (layer * 2 + b) * D + col + 4);
          sh[0] = a.x; sh[1] = a.y; sh[2] = a.z; sh[3] = a.w; sh[4] = c.x; sh[5] = c.y; sh[6] = c.z; sh[7] = c.w; }
#pragma unroll
        for (int e = 0; e < 8; ++e) S[e] = 0.f;
        for (int j = 1; j < w; ++j) { if (tb - j >= 0) { load_x8<XF32>(xsrc, (size_t)(rb - j) * D + col, xv); const float r = rs[ib - j];
#pragma unroll
            for (int e = 0; e < 8; ++e) S[e] += xv[e] * r * gm[e] + sh[e]; } }
#pragma unroll 4
        for (int i = 0; i < 32; ++i) {
            const int t = tb + i;
            load_x8<XF32>(xsrc, (size_t)(rb + i) * D + col, xv);
            const float r = rs[ib + i]; const float inv = __builtin_amdgcn_rcpf((float)((t + 1 < w) ? (t + 1) : w));
            float dv[8];
#pragma unroll
            for (int e = 0; e < 8; ++e) { const float h = xv[e] * r * gm[e] + sh[e]; S[e] += h; dv[e] = S[e] * inv - h; }
            v4u o; o.x = pg8::cvt_pk_bf16(dv[0], dv[1]); o.y = pg8::cvt_pk_bf16(dv[2], dv[3]); o.z = pg8::cvt_pk_bf16(dv[4], dv[5]); o.w = pg8::cvt_pk_bf16(dv[6], dv[7]);
            *(GAS v4u*)(dst + (size_t)(rb + i) * D + col) = o;
            if (t - w + 1 >= 0) { load_x8<XF32>(xsrc, (size_t)(rb + i - w + 1) * D + col, xv); const float ro = rs[ib + i - w + 1];
#pragma unroll
                for (int e = 0; e < 8; ++e) S[e] -= xv[e] * ro * gm[e] + sh[e]; }
        }
    }
}
typedef short bf16x8_t __attribute__((ext_vector_type(8)));
__device__ __forceinline__ bf16x8_t frag2(const LAS unsigned char* p0, const LAS unsigned char* p1) {
    const v2u a = *(const LAS v2u*)p0, b = *(const LAS v2u*)p1; v4u r; r.x = a.x; r.y = a.y; r.z = b.x; r.w = b.y; return __builtin_bit_cast(bf16x8_t, r);
}
typedef short s16x4_t __attribute__((ext_vector_type(4)));
__device__ __forceinline__ bf16x8_t fragtr(const LAS unsigned char* p0, const LAS unsigned char* p1) {
    const s16x4_t a = __builtin_amdgcn_ds_read_tr16_b64_v4i16((LAS s16x4_t*)p0), b = __builtin_amdgcn_ds_read_tr16_b64_v4i16((LAS s16x4_t*)p1);
    const v2u ua = __builtin_bit_cast(v2u, a), ub = __builtin_bit_cast(v2u, b); v4u r; r.x = ua.x; r.y = ua.y; r.z = ub.x; r.w = ub.y; return __builtin_bit_cast(bf16x8_t, r);
}
__device__ __forceinline__ bf16x8_t packf(const f32x4 lo, const f32x4 hi) {
    v4u r; r.x = pg8::cvt_pk_bf16(lo.x, lo.y); r.y = pg8::cvt_pk_bf16(lo.z, lo.w); r.z = pg8::cvt_pk_bf16(hi.x, hi.y); r.w = pg8::cvt_pk_bf16(hi.z, hi.w); return __builtin_bit_cast(bf16x8_t, r);
}
template <int CTRL, int ROWMASK> __device__ __forceinline__ float dpp_f(float v) { return __builtin_bit_cast(float, __builtin_amdgcn_update_dpp(0, __builtin_bit_cast(int, v), CTRL, ROWMASK, 0xF, false)); }
namespace recl { constexpr int C = 32, QS = 272, TS = 288, OSS = 528;
    constexpr int DEC = 0, QH = 512, KT = QH + 32 * QS, KH = KT + 32 * QS, V = KH + 32 * TS, OS = V + 32 * TS, SET = OS + 32 * OSS; }
template <bool P2>
__device__ __forceinline__ void rec_prep(LAS unsigned char* lds, const v4u cq, const v4u clf, const v4u cv, const int lane, const int pt, const int pd8, float (&btot)[8]) {
    using namespace recl;
    float lf[8], x[8], bend[8];
    lf[0] = bflo(clf.x); lf[1] = bfhi(clf.x); lf[2] = bflo(clf.y); lf[3] = bfhi(clf.y); lf[4] = bflo(clf.z); lf[5] = bfhi(clf.z); lf[6] = bflo(clf.w); lf[7] = bfhi(clf.w);
#pragma unroll
    for (int e = 0; e < 8; ++e) { float xx = lf[e];
        xx += dpp_f<0x111, 0xF>(xx); xx += dpp_f<0x112, 0xF>(xx); xx += dpp_f<0x114, 0xF>(xx); xx += dpp_f<0x118, 0xF>(xx); xx += dpp_f<0x142, 0xA>(xx);
        x[e] = xx; const float e0v = __builtin_bit_cast(float, __builtin_amdgcn_readlane(__builtin_bit_cast(int, xx), 31)), e1v = __builtin_bit_cast(float, __builtin_amdgcn_readlane(__builtin_bit_cast(int, xx), 63));
        bend[e] = (lane < 32) ? e0v : e1v; }
    float qh[8], kt[8], kh[8];
    { float qq[8];
      qq[0] = bflo(cq.x); qq[1] = bfhi(cq.x); qq[2] = bflo(cq.y); qq[3] = bfhi(cq.y); qq[4] = bflo(cq.z); qq[5] = bfhi(cq.z); qq[6] = bflo(cq.w); qq[7] = bfhi(cq.w);
#pragma unroll
      for (int e = 0; e < 8; ++e) { const float bb = x[e], k = 1.0f - __expf(lf[e]);
          kh[e] = k * __expf(bend[e] - bb);
          if (P2) { qh[e] = qq[e] * __expf(bb); kt[e] = k * __expf(-bb); } else { qh[e] = 0.f; kt[e] = 0.f; btot[e] += bend[e]; } } }
    if (P2) {
        v4u wq, wk; wq.x = pg8::cvt_pk_bf16(qh[0], qh[1]); wq.y = pg8::cvt_pk_bf16(qh[2], qh[3]); wq.z = pg8::cvt_pk_bf16(qh[4], qh[5]); wq.w = pg8::cvt_pk_bf16(qh[6], qh[7]);
        wk.x = pg8::cvt_pk_bf16(kt[0], kt[1]); wk.y = pg8::cvt_pk_bf16(kt[2], kt[3]); wk.z = pg8::cvt_pk_bf16(kt[4], kt[5]); wk.w = pg8::cvt_pk_bf16(kt[6], kt[7]);
        *(LAS v4u*)(lds + QH + pt * QS + pd8 * 2) = wq; *(LAS v4u*)(lds + KT + pt * QS + pd8 * 2) = wk;
    }
    { v4u wh; wh.x = pg8::cvt_pk_bf16(kh[0], kh[1]); wh.y = pg8::cvt_pk_bf16(kh[2], kh[3]); wh.z = pg8::cvt_pk_bf16(kh[4], kh[5]); wh.w = pg8::cvt_pk_bf16(kh[6], kh[7]);
      *(LAS v4u*)(lds + KH + pt * TS + pd8 * 2) = wh; *(LAS v4u*)(lds + V + pt * TS + pd8 * 2) = cv; }
    if (pt == 31) { *(LAS f32x4*)(lds + DEC + pd8 * 4) = (f32x4){__expf(bend[0]), __expf(bend[1]), __expf(bend[2]), __expf(bend[3])};
                    *(LAS f32x4*)(lds + DEC + (pd8 + 4) * 4) = (f32x4){__expf(bend[4]), __expf(bend[5]), __expf(bend[6]), __expf(bend[7])}; }
}
template <bool P2, int RX = 0>
__device__ __forceinline__ void phase_rec(Frame& F, int j) {
    using namespace recl;
    constexpr int SEGLEN = MK_SEGLEN, NCH = SEGLEN / C, NSEG = SEQ / SEGLEN;
    static_assert(2 * SET <= RING_BYTES, "rec LDS");
    const int item = blockIdx.x; if (item >= BATCH * HEADS * NSEG) return;
    const int seq = item / NSEG, p = item % NSEG, b = seq >> 4, h = seq & 15;
    if (!P2 && p == NSEG - 1) return;
    LAS unsigned char* lds0 = F.lds + RING_OFF;
    const int tid = F.tid, lane = F.lane, w = F.wave, fr = lane & 15, g = lane >> 4;
    const int t = tid >> 4, d8 = (tid & 15) * 8;
    const int pt = lane & 31, pd8 = 16 * w + 8 * (lane >> 5);
    const bf16* Q = (const bf16*)(F.ws + WS_PROJ); const bf16* LF = Q + (size_t)M * D; const bf16* V_ = LF + (size_t)M * D; const bf16* Gt = V_ + (size_t)M * D;
    bf16* O = (bf16*)(F.ws + WS_AOP);
    float* Lst = (float*)(F.ws + WS_REC); float* DT = (float*)(F.ws + WS_REC + 16 * MiB);
    const size_t rowb = (size_t)b * SEQ + (size_t)p * SEGLEN;
    const size_t e0 = (rowb + t) * D + h * HD + d8, pe0 = (rowb + pt) * D + h * HD + pd8;
    f32x4 S[8];
#pragma unroll
    for (int i = 0; i < 8; ++i) S[i] = (f32x4){0.f, 0.f, 0.f, 0.f};
    float btot[8];
#pragma unroll
    for (int e = 0; e < 8; ++e) btot[e] = 0.f;
    if (P2) {
        for (int pp = 0; pp < p; ++pp) {
            const int it2 = seq * NSEG + pp;
#pragma unroll
            for (int dt = 0; dt < 8; ++dt) {
                const f32x4 dc = *(const GAS f32x4*)(DT + (size_t)it2 * HD + 16 * dt + 4 * g);
                const f32x4 lv = *(const GAS f32x4*)(Lst + ((((size_t)it2 * 8 + w) * 8 + dt) * 64 + lane) * 4);
                S[dt] = S[dt] * dc + lv;
            }
        }
    }
    f32x4 ga = {0.f, 0.f, 0.f, 0.f}, gb = ga;
    if (P2) { ga = *(const GAS f32x4*)(F.hgain + (size_t)j * D + h * HD + d8); gb = *(const GAS f32x4*)(F.hgain + (size_t)j * D + h * HD + d8 + 4); }
    const v4u z4u = {0u, 0u, 0u, 0u};
    { const v4u q0 = P2 ? *(const GAS v4u*)(Q + pe0) : z4u, l0 = *(const GAS v4u*)(LF + pe0), v0 = *(const GAS v4u*)(V_ + pe0);
      rec_prep<P2>(lds0, q0, l0, v0, lane, pt, pd8, btot); }
    v4u nq = z4u, nlf = z4u, nv = z4u;
    if (NCH > 1) { const size_t adv = (size_t)C * D; nlf = *(const GAS v4u*)(LF + pe0 + adv); nv = *(const GAS v4u*)(V_ + pe0 + adv); if (P2) nq = *(const GAS v4u*)(Q + pe0 + adv); }
    __syncthreads();
    for (int c = 0; c < NCH; ++c) {
        LAS unsigned char* lds = lds0 + (c & 1) * SET;
        LAS unsigned char* ldn = lds0 + ((c + 1) & 1) * SET;
        v4u cg = z4u; if (P2) cg = *(const GAS v4u*)(Gt + e0 + (size_t)c * C * D);
        const v4u cq = nq, clf = nlf, cv = nv;
        if (c + 2 < NCH) { const size_t adv = (size_t)(c + 2) * C * D;
            nlf = *(const GAS v4u*)(LF + pe0 + adv); nv = *(const GAS v4u*)(V_ + pe0 + adv); if (P2) nq = *(const GAS v4u*)(Q + pe0 + adv); }
        if (c + 1 < NCH) rec_prep<P2>(ldn, cq, clf, cv, lane, pt, pd8, btot);
        if (!(RX & 1)) {
        const int trq = fr >> 2, trp = fr & 3;
        const bf16x8_t vf = fragtr(lds + V + (4 * g + trq) * TS + (16 * w + 4 * trp) * 2, lds + V + (16 + 4 * g + trq) * TS + (16 * w + 4 * trp) * 2);
        if (P2) {
            bf16x8_t qf[2][4];
#pragma unroll
            for (int tt = 0; tt < 2; ++tt)
#pragma unroll
                for (int ks = 0; ks < 4; ++ks) qf[tt][ks] = frag2(lds + QH + (16 * tt + fr) * QS + (32 * ks + 4 * g) * 2, lds + QH + (16 * tt + fr) * QS + (32 * ks + 16 + 4 * g) * 2);
            f32x4 at0 = {0.f, 0.f, 0.f, 0.f}, at1 = at0, at2 = at0, o0 = at0, o1 = at0;
#pragma unroll
            for (int ks = 0; ks < 4; ++ks) { const bf16x8_t sf = packf(S[2 * ks], S[2 * ks + 1]);
                o0 = __builtin_amdgcn_mfma_f32_16x16x32_bf16(qf[0][ks], sf, o0, 0, 0, 0);
                o1 = __builtin_amdgcn_mfma_f32_16x16x32_bf16(qf[1][ks], sf, o1, 0, 0, 0); }
#pragma unroll
            for (int ks = 0; ks < 4; ++ks) {
                const bf16x8_t k0 = frag2(lds + KT + fr * QS + (32 * ks + 4 * g) * 2, lds + KT + fr * QS + (32 * ks + 16 + 4 * g) * 2);
                const bf16x8_t k1 = frag2(lds + KT + (16 + fr) * QS + (32 * ks + 4 * g) * 2, lds + KT + (16 + fr) * QS + (32 * ks + 16 + 4 * g) * 2);
                at0 = __builtin_amdgcn_mfma_f32_16x16x32_bf16(k0, qf[0][ks], at0, 0, 0, 0);
                at1 = __builtin_amdgcn_mfma_f32_16x16x32_bf16(k0, qf[1][ks], at1, 0, 0, 0);
                at2 = __builtin_amdgcn_mfma_f32_16x16x32_bf16(k1, qf[1][ks], at2, 0, 0, 0);
            }
#pragma unroll
            for (int r = 0; r < 4; ++r) { const bool keep = (4 * g + r) <= fr; at0[r] = keep ? at0[r] : 0.f; at2[r] = keep ? at2[r] : 0.f; }
            const f32x4 z4 = {0.f, 0.f, 0.f, 0.f};
            const bf16x8_t af0 = packf(at0, z4), af1 = packf(at1, at2);
            o0 = __builtin_amdgcn_mfma_f32_16x16x32_bf16(af0, vf, o0, 0, 0, 0);
            o1 = __builtin_amdgcn_mfma_f32_16x16x32_bf16(af1, vf, o1, 0, 0, 0);
#pragma unroll
            for (int r = 0; r < 4; ++r) { *(LAS float*)(lds + OS + (4 * g + r) * OSS + (16 * w + fr) * 4) = o0[r]; *(LAS float*)(lds + OS + (16 + 4 * g + r) * OSS + (16 * w + fr) * 4) = o1[r]; }
        }
#pragma unroll
        for (int dt = 0; dt < 8; ++dt) {
            const bf16x8_t hf = fragtr(lds + KH + (4 * g + trq) * TS + (16 * dt + 4 * trp) * 2, lds + KH + (16 + 4 * g + trq) * TS + (16 * dt + 4 * trp) * 2);
            const f32x4 dc = *(const LAS f32x4*)(lds + DEC + (16 * dt + 4 * g) * 4);
            S[dt] = __builtin_amdgcn_mfma_f32_16x16x32_bf16(hf, vf, S[dt] * dc, 0, 0, 0);
        }
        }
        __syncthreads();
        if (P2 && !(RX & 4)) {
            const f32x4 oa = *(const LAS f32x4*)(lds + OS + t * OSS + d8 * 4), ob = *(const LAS f32x4*)(lds + OS + t * OSS + (d8 + 4) * 4);
            float sq = (oa.x * oa.x + oa.y * oa.y) + (oa.z * oa.z + oa.w * oa.w) + (ob.x * ob.x + ob.y * ob.y) + (ob.z * ob.z + ob.w * ob.w);
            sq += __shfl_xor(sq, 1); sq += __shfl_xor(sq, 2); sq += __shfl_xor(sq, 4); sq += __shfl_xor(sq, 8);
            const float rstd = rsqrtf(sq * (1.0f / HD) + EPS);
            const float r0 = oa.x * rstd * ga.x * bflo(cg.x), r1 = oa.y * rstd * ga.y * bfhi(cg.x), r2 = oa.z * rstd * ga.z * bflo(cg.y), r3 = oa.w * rstd * ga.w * bfhi(cg.y);
            const float r4 = ob.x * rstd * gb.x * bflo(cg.z), r5 = ob.y * rstd * gb.y * bfhi(cg.z), r6 = ob.z * rstd * gb.z * bflo(cg.w), r7 = ob.w * rstd * gb.w * bfhi(cg.w);
            v4u wo; wo.x = pg8::cvt_pk_bf16(r0, r1); wo.y = pg8::cvt_pk_bf16(r2, r3); wo.z = pg8::cvt_pk_bf16(r4, r5); wo.w = pg8::cvt_pk_bf16(r6, r7);
            *(GAS v4u*)(O + e0 + (size_t)c * C * D) = wo;
        }
    }
    if (!P2) {
#pragma unroll
        for (int dt = 0; dt < 8; ++dt) *(GAS f32x4*)(Lst + ((((size_t)item * 8 + w) * 8 + dt) * 64 + lane) * 4) = S[dt];
        if (pt == 0) {
#pragma unroll
            for (int e = 0; e < 8; ++e) DT[(size_t)item * HD + pd8 + e] = __expf(btot[e]);
        }
    }
}
__device__ __forceinline__ void phase_final(Frame& F) {
    const int gw = blockIdx.x * NWAVES + F.wave, NGW = F.G * NWAVES;
    const unsigned short* X = (const unsigned short*)(F.ws + WS_X); const float* ss = (const float*)(F.ws + WS_SS);
    v4u nx[4]; float ns = 0.f;
    if (gw < M) {
#pragma unroll
        for (int j = 0; j < 4; ++j) nx[j] = *((const GAS v4u*)(X + (size_t)gw * D) + F.lane + 64 * j);
        ns = (F.lane < 32) ? ss[(size_t)gw * 32 + F.lane] : 0.f; }
    for (int m = gw; m < M; m += NGW) {
        v4u cx[4];
#pragma unroll
        for (int j = 0; j < 4; ++j) cx[j] = nx[j];
        const float cs = ns; const int mn = m + NGW;
        if (mn < M) {
#pragma unroll
            for (int j = 0; j < 4; ++j) nx[j] = *((const GAS v4u*)(X + (size_t)mn * D) + F.lane + 64 * j);
            ns = (F.lane < 32) ? ss[(size_t)mn * 32 + F.lane] : 0.f; }
        const float rstd = rsqrtf(wave_sum(cs) * (1.0f / D) + EPS);
        GAS f32x4* orow = (GAS f32x4*)(F.out + (size_t)m * D) + 2 * F.lane; const GAS f32x4* gr = (const GAS f32x4*)F.fgain + 2 * F.lane;
#pragma unroll
        for (int j = 0; j < 4; ++j) { const f32x2_t p0 = unph2(cx[j].x), p1 = unph2(cx[j].y), p2 = unph2(cx[j].z), p3 = unph2(cx[j].w);
            orow[128 * j] = (f32x4){p0.x, p0.y, p1.x, p1.y} * rstd * gr[128 * j]; orow[128 * j + 1] = (f32x4){p2.x, p2.y, p3.x, p3.y} * rstd * gr[128 * j + 1]; }
    }
}

__device__ __forceinline__ float row_rstd(const float* ss, int row, int fq) {
    const f32x4 a = *(const GAS f32x4*)(ss + (size_t)row * 32 + fq * 8), b = *(const GAS f32x4*)(ss + (size_t)row * 32 + fq * 8 + 4);
    float s = ((a.x + a.y) + (a.z + a.w)) + ((b.x + b.y) + (b.z + b.w));
    s += __shfl_xor(s, 16); s += __shfl_xor(s, 32);
    return rsqrtf(s * (1.0f / D) + EPS);
}
template <bool XF32, bool WXG = true> struct EpiResid {
    static constexpr bool PERM = true; static constexpr bool BJ32 = true;
    const void* xin; void* xr; bf16* xg; float* ss; const float* gate; const float* gnext;
    __device__ __forceinline__ void operator()(const pg8::f32x4 (&acc)[2][2][4][2], const pg8::Unit& u, int wr, int wc, int fr, int fq) const {
        const int b = u.pm >> 5, row0 = u.pm * 256 + wr * 64 + fr, col0 = u.pn * 256 + wc * 64 + 8 * fq;
        f32x4 gt[2][2], gn[2][2];
#pragma unroll
        for (int bj = 0; bj < 2; ++bj)
#pragma unroll
            for (int n = 0; n < 2; ++n) { gt[bj][n] = *(const GAS f32x4*)(gate + b * D + col0 + bj * 32 + 4 * n); gn[bj][n] = *(const GAS f32x4*)(gnext + b * D + col0 + bj * 32 + 4 * n); }
        const bool lo = fr < 8;
        auto swap8 = [&](const v4u& a0, const v4u& a1, v4u& s1, v4u& s2) {
            v4u snd, rcv; snd.x = lo ? a1.x : a0.x; snd.y = lo ? a1.y : a0.y; snd.z = lo ? a1.z : a0.z; snd.w = lo ? a1.w : a0.w;
            rcv.x = (unsigned)__builtin_amdgcn_update_dpp(0, (int)snd.x, 0x128, 0xf, 0xf, false); rcv.y = (unsigned)__builtin_amdgcn_update_dpp(0, (int)snd.y, 0x128, 0xf, 0xf, false);
            rcv.z = (unsigned)__builtin_amdgcn_update_dpp(0, (int)snd.z, 0x128, 0xf, 0xf, false); rcv.w = (unsigned)__builtin_amdgcn_update_dpp(0, (int)snd.w, 0x128, 0xf, 0xf, false);
            s1.x = lo ? a0.x : rcv.x; s1.y = lo ? a0.y : rcv.y; s1.z = lo ? a0.z : rcv.z; s1.w = lo ? a0.w : rcv.w;
            s2.x = lo ? rcv.x : a1.x; s2.y = lo ? rcv.y : a1.y; s2.z = lo ? rcv.z : a1.z; s2.w = lo ? rcv.w : a1.w; };
        const int srow = (fr & 7) - fr, scol = lo ? 0 : 32;
#pragma unroll
        for (int ai = 0; ai < 2; ++ai)
#pragma unroll
            for (int m = 0; m < 4; ++m) {
                const int row = row0 + ai * 128 + m * 16; const size_t ro = (size_t)row * D + col0; float sq = 0.f;
                v4u wx[2], wg[2];
#pragma unroll
                for (int bj = 0; bj < 2; ++bj) {
                    f32x4 x0, x1;
                    if (XF32) { x0 = *(const GAS f32x4*)((const float*)xin + ro + bj * 32); x1 = *(const GAS f32x4*)((const float*)xin + ro + bj * 32 + 4); }
                    else { const v4u xb = *(const GAS v4u*)((const unsigned short*)xin + ro + bj * 32); const f32x2_t p0 = unph2(xb.x), p1 = unph2(xb.y), p2 = unph2(xb.z), p3 = unph2(xb.w);
                        x0 = (f32x4){p0.x, p0.y, p1.x, p1.y}; x1 = (f32x4){p2.x, p2.y, p3.x, p3.y}; }
                    const f32x4 v0 = x0 + gt[bj][0] * acc[ai][bj][m][0], v1 = x1 + gt[bj][1] * acc[ai][bj][m][1];
                    wx[bj].x = pkh2(v0.x, v0.y); wx[bj].y = pkh2(v0.z, v0.w); wx[bj].z = pkh2(v1.x, v1.y); wx[bj].w = pkh2(v1.z, v1.w);
                    sq += (v0.x * v0.x + v0.y * v0.y) + (v0.z * v0.z + v0.w * v0.w) + (v1.x * v1.x + v1.y * v1.y) + (v1.z * v1.z + v1.w * v1.w);
                    if (WXG) { const f32x4 g0 = v0 * gn[bj][0], g1 = v1 * gn[bj][1];
                        wg[bj].x = pg8::cvt_pk_bf16(g0.x, g0.y); wg[bj].y = pg8::cvt_pk_bf16(g0.z, g0.w); wg[bj].z = pg8::cvt_pk_bf16(g1.x, g1.y); wg[bj].w = pg8::cvt_pk_bf16(g1.z, g1.w); }
                }
                const size_t so = (size_t)(row + srow) * D + col0 + scol;
                { v4u s1, s2; swap8(wx[0], wx[1], s1, s2);
                    __builtin_nontemporal_store(s1, (GAS v4u*)((unsigned short*)xr + so)); __builtin_nontemporal_store(s2, (GAS v4u*)((unsigned short*)xr + so + 8 * D)); }
                if (WXG) { v4u s1, s2; swap8(wg[0], wg[1], s1, s2); *(GAS v4u*)(xg + so) = s1; *(GAS v4u*)(xg + so + 8 * D) = s2; }
                sq += __shfl_xor(sq, 16); sq += __shfl_xor(sq, 32);
                if (fq == 0) ss[(size_t)row * 32 + u.pn * 4 + wc] = sq;
            }
    }
};
constexpr int RS_OFF = RING_BYTES + 1024;
__device__ __forceinline__ void phase_row_rstd(Frame& F, const float* ss, int pm) {
    if (F.tid < 256) { const float* p = ss + ((size_t)pm * 256 + F.tid) * 32; float s = 0.f;
#pragma unroll
        for (int q = 0; q < 8; ++q) { const f32x4 a = *(const GAS f32x4*)(p + 4 * q); s += (a.x + a.y) + (a.z + a.w); }
        ((LAS float*)(F.lds + RS_OFF))[F.tid] = rsqrtf(s * (1.0f / D) + EPS); }
    __syncthreads();
}
struct EpiSwiglu {
    static constexpr bool PERM = true; static constexpr bool BJ32 = false;
    const LAS float* rs; const float* bias; bf16* hid;
    __device__ __forceinline__ void operator()(const pg8::f32x4 (&acc)[2][2][4][2], const pg8::Unit& u, int wr, int wc, int fr, int fq) const {
        const int b = u.pm >> 5, row0 = u.pm * 256 + wr * 64 + fr, cin = u.pn * 256 + wc * 32 + 8 * fq, cout = u.pn * 128 + wc * 32 + 8 * fq;
        f32x4 bs[2][2];
#pragma unroll
        for (int bj = 0; bj < 2; ++bj)
#pragma unroll
            for (int n = 0; n < 2; ++n) bs[bj][n] = *(const GAS f32x4*)(bias + (size_t)b * NFF2 + cin + bj * 128 + 4 * n);
#pragma unroll
        for (int ai = 0; ai < 2; ++ai)
#pragma unroll
            for (int m = 0; m < 4; ++m) {
                const int row = row0 + ai * 128 + m * 16; const float rstd = rs[ai * 128 + wr * 64 + m * 16 + fr];
                float hv[8];
#pragma unroll
                for (int n = 0; n < 2; ++n) { const f32x4 a = acc[ai][0][m][n] * rstd + bs[0][n], bb = acc[ai][1][m][n] * rstd + bs[1][n];
#pragma unroll
                    for (int e = 0; e < 4; ++e) hv[4 * n + e] = a[e] * sigmoidf_(a[e]) * bb[e]; }
                v4u w; w.x = pg8::cvt_pk_bf16(hv[0], hv[1]); w.y = pg8::cvt_pk_bf16(hv[2], hv[3]); w.z = pg8::cvt_pk_bf16(hv[4], hv[5]); w.w = pg8::cvt_pk_bf16(hv[6], hv[7]);
                *(GAS v4u*)(hid + (size_t)row * DFF + cout) = w;
            }
    }
};
struct EpiProj {
    static constexpr bool PERM = true; static constexpr bool BJ32 = false;
    const LAS float* rs; const float* bias; const float* lb; bf16* out;
    template <int TYP> __device__ __forceinline__ void body(const pg8::f32x4 (&acc)[2][2][4][2], const pg8::Unit& u, int wr, int wc, int fr, int fq) const {
        const int b = u.pm >> 5, row0 = u.pm * 256 + wr * 64 + fr, cin = u.pn * 256 + wc * 32 + 8 * fq, cout = (u.pn & 7) * 256 + wc * 32 + 8 * fq;
        bf16* dst = out + (size_t)TYP * M * D;
        f32x4 bs[2][2], lbv[2][2];
#pragma unroll
        for (int bj = 0; bj < 2; ++bj)
#pragma unroll
            for (int n = 0; n < 2; ++n) { bs[bj][n] = *(const GAS f32x4*)(bias + (size_t)b * NPROJ + cin + bj * 128 + 4 * n); lbv[bj][n] = (TYP == 1) ? *(const GAS f32x4*)(lb + cout + bj * 128 + 4 * n) : (f32x4){0.f, 0.f, 0.f, 0.f}; }
#pragma unroll
        for (int ai = 0; ai < 2; ++ai)
#pragma unroll
            for (int m = 0; m < 4; ++m) {
                const int row = row0 + ai * 128 + m * 16; const float rstd = rs[ai * 128 + wr * 64 + m * 16 + fr];
#pragma unroll
                for (int bj = 0; bj < 2; ++bj) {
                    float r[8];
#pragma unroll
                    for (int n = 0; n < 2; ++n) { const f32x4 v = acc[ai][bj][m][n] * rstd + bs[bj][n];
#pragma unroll
                        for (int e = 0; e < 4; ++e) { float x = v[e];
                            if (TYP == 1) { const float lo = lbv[bj][n][e]; x = __logf(lo + (1.0f - lo) * sigmoidf_(x)); }
                            if (TYP == 3) x = x * sigmoidf_(x);
                            r[4 * n + e] = x; } }
                    v4u w; w.x = pg8::cvt_pk_bf16(r[0], r[1]); w.y = pg8::cvt_pk_bf16(r[2], r[3]); w.z = pg8::cvt_pk_bf16(r[4], r[5]); w.w = pg8::cvt_pk_bf16(r[6], r[7]);
                    *(GAS v4u*)(dst + (size_t)row * D + cout + bj * 128) = w;
                }
            }
    }
    __device__ __forceinline__ void operator()(const pg8::f32x4 (&acc)[2][2][4][2], const pg8::Unit& u, int wr, int wc, int fr, int fq) const {
        const int typ = u.pn >> 3;
        if (typ == 1) body<1>(acc, u, wr, wc, fr, fq); else if (typ == 3) body<3>(acc, u, wr, wc, fr, fq); else if (typ == 0) body<0>(acc, u, wr, wc, fr, fq); else body<2>(acc, u, wr, wc, fr, fq);
    }
};
struct EpiNull {
    static constexpr bool PERM = true; static constexpr bool BJ32 = false;
    float* dummy;
    __device__ __forceinline__ void operator()(const pg8::f32x4 (&acc)[2][2][4][2], const pg8::Unit& u, int wr, int wc, int fr, int fq) const {
        f32x4 s = {0.f, 0.f, 0.f, 0.f};
#pragma unroll
        for (int ai = 0; ai < 2; ++ai)
#pragma unroll
            for (int bj = 0; bj < 2; ++bj)
#pragma unroll
                for (int m = 0; m < 4; ++m)
#pragma unroll
                    for (int n = 0; n < 2; ++n) s += acc[ai][bj][m][n];
        if (s.x + s.y + s.z + s.w == 12345.678f) dummy[(u.pm * 64 + u.pn) * 512 + threadIdx.x] = s.x;
    }
};
#ifndef MK_RX
#define MK_RX 0
#endif
#ifndef MK_XP
#define MK_XP 0
#endif
#ifndef MK_REPEAT_NULL
#define MK_REPEAT_NULL 0
#endif
#ifndef MK_REPEAT
#define MK_REPEAT -1
#endif
#ifndef MK_REPEAT_N
#define MK_REPEAT_N 1
#endif
#ifndef MK_NAIVE_REC
#define MK_NAIVE_REC 0
#endif
#ifndef MK_SP2
#define MK_SP2 true
#endif
#ifndef MK_ALIGN
#define MK_ALIGN true
#endif

struct Args { const float* in[15]; float* out; unsigned char* ws; int ph_lo, ph_hi; };
struct RowSplitOrder : pg8::StaticOrder {
    __device__ bool next(int i, pg8::Unit& u) const {
        if (G != 256 || nM != 64 || nN != 8) return pg8::StaticOrder::next(i, u);
        if (i >= 2) return false;
        const int x = c & 7, off = c >> 3; u.pm = 8 * x + 4 * i + (off & 3); u.pn = off >> 2; return true;
    }
};
template <int l> __device__ __forceinline__ void layer_phases(Frame& F, const Args& args, const XcdBarrier& bar, int lo, int hi) {
#define IN(k) (lo <= (k) && (k) < hi)
#define SEAM(k) do { if (IN(k) && IN((k) + 1)) xcd_barrier(bar, F.wave); } while (0)
#define RUNPH(k, ...) do { if (IN(k)) { F.lane = lane_id(); F.tid = F.wave * 64 + F.lane; if (MK_REPEAT == (k)) { _Pragma("unroll") for (int _r = 0; _r < MK_REPEAT_N; ++_r) { { __VA_ARGS__ } xcd_barrier(bar, F.wave); } } { __VA_ARGS__ } } } while (0)
    unsigned short* X = (unsigned short*)(args.ws + WS_X); bf16* XG = (bf16*)(args.ws + WS_XG); bf16* AOP = (bf16*)(args.ws + WS_AOP); bf16* HID = (bf16*)(args.ws + WS_HID); bf16* PROJ = (bf16*)(args.ws + WS_PROJ);
    float* SS = (float*)(args.ws + WS_SS);
    unsigned short* DX = (unsigned short*)(args.ws + WS_END); bf16* DXG = (bf16*)(args.ws + WS_END + 128 * MiB); float* DSS = (float*)(args.ws + WS_END + 192 * MiB);
    int rep_i = 0; (void)rep_i; (void)DX; (void)DXG; (void)DSS;
    constexpr int pb = 3 + (l >> 1) * 10 + (l & 1) * 4, j = l >> 1;
    constexpr bool pool = (l & 1) == 0;
    constexpr int pf = pool ? pb + 2 : pb + 4;
    const void* xsrc = (l == 0) ? (const void*)F.x : (const void*)X;
    if constexpr (pool) {
        if constexpr (l != 0) { RUNPH(pb, phase_poolprep<false>(F, l, xsrc);); SEAM(pb); }
    } else {
        RUNPH(pb,
            pg8::Gemm g{XG, (const bf16*)(args.ws + WS_WHIN) + (size_t)j * NPROJ * D, D, D, D, 0}; pg8::StaticOrder S; S.init(M, NPROJ, F.G, (int)blockIdx.x);
            { pg8::Unit u0; if (S.next(0, u0)) phase_row_rstd(F, SS, u0.pm); }
            EpiProj E{(const LAS float*)(F.lds + RS_OFF), F.vec + V_BIASP + (size_t)j * 2 * NPROJ, F.vec + V_LB + j * D, PROJ};
            pg8::gemm_phase<EpiProj, pg8::StaticOrder, MK_ALIGN, MK_SP2>(F.lds + RING_OFF, g, S, E, F.wave);
        ); SEAM(pb);
        RUNPH(pb + 1, phase_rec<false>(F, j);); SEAM(pb + 1);
        RUNPH(pb + 2, if (MK_RX != 0 && MK_REPEAT == pb + 2 && rep_i++ < MK_REPEAT_N) phase_rec<true, MK_RX>(F, j); else phase_rec<true>(F, j);); SEAM(pb + 2);
    }
    RUNPH(pf - 1,
        const bool dmy = (MK_REPEAT == pf - 1) && (rep_i++ < MK_REPEAT_N);
        pg8::Gemm g{AOP, pool ? (const bf16*)(args.ws + WS_WPOOL) + (size_t)j * 4 * PGD * PGD : (const bf16*)(args.ws + WS_WHOUT) + (size_t)j * D * D, D, pool ? PGD : D, pool ? PGD : D, pool ? PGD * 2 : 0};
        RowSplitOrder S; S.init(M, D, F.G, (int)blockIdx.x);
        EpiResid<l == 0> E{xsrc, dmy ? DX : X, dmy ? DXG : XG, dmy ? DSS : SS, F.vec + V_GATEM + l * 2 * D, F.vec + V_GF + l * 2 * D};
        pg8::gemm_phase<EpiResid<l == 0>, RowSplitOrder, MK_ALIGN, MK_SP2>(F.lds + RING_OFF, g, S, E, F.wave);
    ); SEAM(pf - 1);
    RUNPH(pf,
        pg8::Gemm g{XG, (const bf16*)(args.ws + WS_WFIN) + (size_t)l * NFF2 * D, D, D, D, 0}; pg8::StaticOrder S; S.init(M, NFF2, F.G, (int)blockIdx.x);
        { pg8::Unit u0; if (S.next(0, u0)) phase_row_rstd(F, SS, u0.pm); }
        if (MK_REPEAT_NULL && MK_REPEAT == pf && rep_i++ < MK_REPEAT_N) { EpiNull E0{DSS}; pg8::gemm_phase<EpiNull, pg8::StaticOrder, MK_ALIGN, MK_SP2, MK_XP>(F.lds + RING_OFF, g, S, E0, F.wave); }
        else {
        EpiSwiglu E{(const LAS float*)(F.lds + RS_OFF), F.vec + V_BIASF + (size_t)l * 2 * NFF2, HID};
        pg8::gemm_phase<EpiSwiglu, pg8::StaticOrder, MK_ALIGN, MK_SP2>(F.lds + RING_OFF, g, S, E, F.wave); }
    ); SEAM(pf);
    RUNPH(pf + 1,
        const bool dmy = (MK_REPEAT == pf + 1) && (rep_i++ < MK_REPEAT_N);
        pg8::Gemm g{HID, (const bf16*)(args.ws + WS_WFOUT) + (size_t)l * D * DFF, DFF, DFF, DFF, 0}; RowSplitOrder S; S.init(M, D, F.G, (int)blockIdx.x);
        EpiResid<false, pool> E{X, dmy ? DX : X, dmy ? DXG : XG, dmy ? DSS : SS, F.vec + V_GATEF + l * 2 * D, F.vec + V_GM + ((l + 1) & 3) * 2 * D};
        pg8::gemm_phase<EpiResid<false, pool>, RowSplitOrder, MK_ALIGN, MK_SP2>(F.lds + RING_OFF, g, S, E, F.wave);
    ); SEAM(pf + 1);
#undef RUNPH
#undef IN
#undef SEAM
}
__global__ void __launch_bounds__(NWAVES * 64, 2) mk_fwd(Args args) {
    extern __shared__ __attribute__((aligned(16))) unsigned char lds[];
    Frame F;
    F.lds = (LAS unsigned char*)lds;
    F.tid = threadIdx.x; F.lane = F.tid & 63; F.wave = __builtin_amdgcn_readfirstlane(F.tid >> 6); F.G = gridDim.x;
    F.x = args.in[0]; F.c = args.in[1]; F.gmix = args.in[2]; F.gffn = args.in[3]; F.wada = args.in[4]; F.bada = args.in[5]; F.poolw = args.in[6]; F.pools = args.in[7];
    F.hwin = args.in[8]; F.hwout = args.in[9]; F.hgain = args.in[10]; F.hlb = args.in[11]; F.wfin = args.in[12]; F.wfout = args.in[13]; F.fgain = args.in[14];
    F.out = args.out; F.ws = args.ws; F.vec = (float*)(args.ws + WS_VEC);
    volatile LAS unsigned* MISC = (volatile LAS unsigned*)(F.lds + MISC_OFF);
    for (int u = F.tid; u < (LDS_BYTES - LDSCTL_OFF) / 4; u += NWAVES * 64) ((LAS unsigned*)(F.lds + LDSCTL_OFF))[u] = 0u;
    __syncthreads();
    const int lo = args.ph_lo, hi = args.ph_hi;
    const bool multi = (hi - lo) > 1;
    XcdBarrier bar; bar.bar = (unsigned*)(args.ws + WS_CTL) + CW_BAR; bar.x = 0; bar.st = nullptr;
    if (multi) bar = xcd_barrier_post((unsigned*)(args.ws + WS_CTL) + CW_BAR, MISC + 8);
#define IN(k) (lo <= (k) && (k) < hi)
#define SEAM(k) do { if (IN(k) && IN((k) + 1)) xcd_barrier(bar, F.wave); } while (0)

#define RUNPH(k, ...) do { if (IN(k)) { F.lane = lane_id(); F.tid = F.wave * 64 + F.lane; if (MK_REPEAT == (k)) { _Pragma("unroll") for (int _r = 0; _r < MK_REPEAT_N; ++_r) { { __VA_ARGS__ } xcd_barrier(bar, F.wave); } } { __VA_ARGS__ } } } while (0)
    RUNPH(0, phase_p0a(F);); SEAM(0);
    RUNPH(1, phase_p0b(F);); SEAM(1);
    RUNPH(2, phase_p0c(F); __syncthreads(); phase_poolprep<true>(F, 0, (const void*)F.x);); SEAM(2);

    layer_phases<0>(F, args, bar, lo, hi); layer_phases<1>(F, args, bar, lo, hi); layer_phases<2>(F, args, bar, lo, hi); layer_phases<3>(F, args, bar, lo, hi);
    RUNPH(NPHASE - 1, phase_final(F););
#undef RUNPH
#undef IN
#undef SEAM
}

#ifndef MK_N_LAUNCHES
#define MK_N_LAUNCHES 1
#endif
extern "C" void kernel_launch(void* const* d_in, const int* in_sizes, int n_in, void* d_out, int out_size, void* d_ws, size_t ws_size, hipStream_t stream) {
    static int grid = 0;
    if (grid == 0) {
        if (n_in != 15 || in_sizes[0] != M * D || out_size != M * D || ws_size < WS_END) { fprintf(stderr, "kernel_launch: unexpected shapes (n_in %d in0 %d out %d ws %zu)\n", n_in, n_in > 0 ? in_sizes[0] : -1, out_size, ws_size); grid = -1; return; }
        int dev = 0, cus = 0, per_cu = 0;
        if (hipGetDevice(&dev) != hipSuccess || hipDeviceGetAttribute(&cus, hipDeviceAttributeMultiprocessorCount, dev) != hipSuccess) { grid = -1; return; }
        if (hipFuncSetAttribute((const void*)mk_fwd, hipFuncAttributeMaxDynamicSharedMemorySize, LDS_BYTES) != hipSuccess) { fprintf(stderr, "kernel_launch: hipFuncSetAttribute failed\n"); grid = -1; return; }
        if (hipOccupancyMaxActiveBlocksPerMultiprocessor(&per_cu, (const void*)mk_fwd, NWAVES * 64, LDS_BYTES) != hipSuccess || per_cu < 1) fprintf(stderr, "kernel_launch: occupancy query says %d\n", per_cu);
        (void)hipGetLastError();
        grid = cus;
    }
    if (grid < 0) return;
    if (hipMemsetAsync((char*)d_ws + WS_CTL, 0, CTL_ZERO_BYTES, stream) != hipSuccess) return;
    Args a{};
    for (int i = 0; i < 15; ++i) a.in[i] = (const float*)d_in[i];
    a.out = (float*)d_out; a.ws = (unsigned char*)d_ws;
    if (MK_N_LAUNCHES == 1) { a.ph_lo = 0; a.ph_hi = NPHASE; hipLaunchKernelGGL(mk_fwd, dim3(grid), dim3(NWAVES * 64), LDS_BYTES, stream, a); }
    else for (int p = 0; p < NPHASE; ++p) { a.ph_lo = p; a.ph_hi = p + 1; hipLaunchKernelGGL(mk_fwd, dim3(grid), dim3(NWAVES * 64), LDS_BYTES, stream, a); }
}
```

```cpp
#include <hip/hip_runtime.h>
#include <cstdio>
#include <cstdint>
namespace pg8 {
#define PG8_LAS __attribute__((address_space(3)))
typedef unsigned short bf16_t;
typedef short bf16x8 __attribute__((ext_vector_type(8)));
typedef float f32x4 __attribute__((ext_vector_type(4)));
typedef unsigned u32x4 __attribute__((ext_vector_type(4)));
constexpr int BM = 256, BK = 64, HALF = 128, HTB = HALF * BK * 2  , STAGE_BYTES = 8 * HTB, NXCD = 8, WGM = 8;

__host__ __device__ __forceinline__ int lds_byte(int r, int c) { const int st = (r >> 4) * 2 + (c >> 5), rr = r & 15, cc = c & 31, ob = rr * 64 + cc * 2; return st * 1024 + (ob ^ (((ob >> 9) & 1) << 5)); }
__host__ __device__ __forceinline__ void stage_rc(int b, int& R, int& C) { const int st = b / 1024, sb = b % 1024, swz = sb ^ (((sb >> 9) & 1) << 5); R = (st >> 1) * 16 + swz / 64; C = (st & 1) * 32 + (swz % 64) / 2; }
__host__ __device__ __forceinline__ int perm32(int rho) { const int n = rho >> 4, i = rho & 15; return 8 * (i >> 2) + 4 * n + (i & 3); }

struct Unit { int pm, pn; };
struct Gemm { const bf16_t* A; const bf16_t* Bt; int lda, ldb, K, agrp_bytes; };

struct StaticOrder {
    int nM, nN, nwg, G, c;
    __host__ __device__ void init(int M, int N, int G_, int c_) { nM = M / BM; nN = N / BM; nwg = nM * nN; G = G_; c = c_; }
    __host__ __device__ bool next(int i, Unit& u) const {
        const long L = (long)i * G + c; if (L >= nwg) return false;
        int wgid = (int)L; { const int q = nwg / NXCD, r = nwg % NXCD, xcd = wgid % NXCD, off = wgid / NXCD; wgid = (xcd < r ? xcd * (q + 1) : r * (q + 1) + (xcd - r) * q) + off; }
        const int nig = WGM * nN, gid = wgid / nig, fm = gid * WGM, gsz = (nM - fm) < WGM ? (nM - fm) : WGM;
        u.pm = fm + ((wgid % nig) % gsz); u.pn = (wgid % nig) / gsz; return true;
    }
    __device__ __forceinline__ void a_ready(const Unit&) const {}
    __device__ __forceinline__ void done(const Unit&) const {}
};

__device__ __forceinline__ unsigned cvt_pk_bf16(float lo, float hi) { typedef float f2_ __attribute__((ext_vector_type(2))); typedef __bf16 b2_ __attribute__((ext_vector_type(2))); const f2_ v = {lo, hi}; return __builtin_bit_cast(unsigned, __builtin_convertvector(v, b2_)); }

template <class Epi, class Sched, bool ALIGN_EPI = false, bool SP2 = false, int XP = 0  >
__device__ __forceinline__ void gemm_phase(PG8_LAS unsigned char* lds, const Gemm g, const Sched& S, const Epi& E, const int wid) {
    const int lane = __builtin_amdgcn_mbcnt_hi(~0u, __builtin_amdgcn_mbcnt_lo(~0u, 0u)), tid = wid * 64 + lane, wr = wid >> 2, wc = wid & 3, fr = lane & 15, fq = lane >> 4;
    const int K = g.K, nt = K / BK;
    unsigned voffA[2], voffB[2];
#pragma unroll
    for (int i = 0; i < 2; ++i) { int R, C; stage_rc(tid * 16 + i * 8192, R, C); const int Rb = Epi::PERM ? ((Epi::BJ32 ? 64 * (R >> 5) : (R & ~31)) + perm32(R & 31)) : R;
        voffA[i] = (unsigned)(R * g.lda + C) * 2u; voffB[i] = (unsigned)(Rb * g.ldb + C) * 2u; }
    const unsigned kstep = (unsigned)(BK * 2);
    const unsigned hstepA = (unsigned)HALF * g.lda * 2, hstepB = (unsigned)(Epi::BJ32 ? 32 : HALF) * g.ldb * 2;
    const unsigned tstepA = 2 * hstepA, tstepB = 2u * HALF * g.ldb * 2;
    const __amdgpu_buffer_rsrc_t rsA = __builtin_amdgcn_make_buffer_rsrc((void*)g.A, (short)0, 0x7ffffff0, 0x00020000), rsB = __builtin_amdgcn_make_buffer_rsrc((void*)g.Bt, (short)0, 0x7ffffff0, 0x00020000);
    const unsigned ldsw = (unsigned)wid * 1024u;
    const int aoff = lds_byte(wr * 64 + fr, fq * 8), boff = lds_byte(wc * 32 + fr, fq * 8);
#define PG8_SA(b, h) (((b) * 2 + (h)) * HTB)
#define PG8_SB(b, h) ((4 + (b) * 2 + (h)) * HTB)
#define PG8_STAGE_A(bufoff, soff, voff) do { if (!(XP & 4)) _Pragma("unroll") for (int _i = 0; _i < 2; ++_i) \
        __builtin_amdgcn_raw_ptr_buffer_load_lds(rsA, (PG8_LAS void*)(lds + (bufoff) + ldsw + _i * 8192), 16, (int)(voff)[_i], (int)(soff), 0, 0); } while (0)
#define PG8_STAGE_B(bufoff, soff, voff) do { if (!(XP & 4)) _Pragma("unroll") for (int _i = 0; _i < 2; ++_i) \
        __builtin_amdgcn_raw_ptr_buffer_load_lds(rsB, (PG8_LAS void*)(lds + (bufoff) + ldsw + _i * 8192), 16, (int)(voff)[_i], (int)(soff), 0, 0); } while (0)
#define PG8_LDA(dst, b, h) do { if (!(XP & 2)) _Pragma("unroll") for (int m = 0; m < 4; ++m) _Pragma("unroll") for (int k = 0; k < 2; ++k) dst[m][k] = *(const PG8_LAS bf16x8*)(lds + PG8_SA(b, h) + aoff + m * 2048 + k * 1024); } while (0)
#define PG8_LDB(dst, b, h) do { if (!(XP & 2)) _Pragma("unroll") for (int n = 0; n < 2; ++n) _Pragma("unroll") for (int k = 0; k < 2; ++k) dst[n][k] = *(const PG8_LAS bf16x8*)(lds + PG8_SB(b, h) + boff + n * 2048 + k * 1024); } while (0)
#define PG8_MMA(ai, bj, At, Bt) do { if (!(XP & 8)) __builtin_amdgcn_s_setprio(1); _Pragma("unroll") for (int m = 0; m < 4; ++m) _Pragma("unroll") for (int n = 0; n < 2; ++n) _Pragma("unroll") for (int k = 0; k < 2; ++k) { \
        if (!(XP & 1)) acc[ai][bj][m][n] = __builtin_amdgcn_mfma_f32_16x16x32_bf16(Bt[n][k], At[m][k], acc[ai][bj][m][n], 0, 0, 0); else asm volatile("" :: "v"(Bt[n][k]), "v"(At[m][k])); } if (!(XP & 8)) __builtin_amdgcn_s_setprio(0); } while (0)
#define PG8_WAIT_V(n) do { if (!(XP & 16)) asm volatile("s_waitcnt vmcnt(" #n ")" ::: "memory"); } while (0)
#define PG8_WAIT_L(n) asm volatile("s_waitcnt lgkmcnt(" #n ")" ::: "memory")
#define PG8_BAR __builtin_amdgcn_s_barrier()
#define PG8_SCHED __builtin_amdgcn_sched_barrier(0)
    Unit cur, nxt; int ui = 0;
    if (!S.next(0, cur)) return;
    f32x4 acc[2][2][4][2];
#pragma unroll
    for (int a = 0; a < 2; ++a)
#pragma unroll
        for (int b = 0; b < 2; ++b)
#pragma unroll
            for (int m = 0; m < 4; ++m)
#pragma unroll
                for (int n = 0; n < 2; ++n) acc[a][b][m][n] = (f32x4){0.f, 0.f, 0.f, 0.f};
    bf16x8 At[4][2], B0[2][2], B1[2][2];
    if (XP & 2) { bf16x8 pat; _Pragma("unroll") for (int q = 0; q < 8; ++q) pat[q] = (short)(0x3c00 + ((tid * 37 + q * 11) & 0x3ff));
        _Pragma("unroll") for (int m = 0; m < 4; ++m) _Pragma("unroll") for (int k = 0; k < 2; ++k) At[m][k] = pat;
        _Pragma("unroll") for (int n = 0; n < 2; ++n) _Pragma("unroll") for (int k = 0; k < 2; ++k) { B0[n][k] = pat; B1[n][k] = pat; } }
    unsigned cA = (unsigned)cur.pm * tstepA + (unsigned)(cur.pn >> 1) * g.agrp_bytes, cB = (unsigned)cur.pn * tstepB;
    S.a_ready(cur);
    if constexpr (SP2) {
        PG8_STAGE_B(PG8_SB(0, 0), cB, voffB); PG8_STAGE_B(PG8_SB(0, 1), cB + hstepB, voffB); PG8_STAGE_A(PG8_SA(0, 0), cA, voffA); PG8_STAGE_A(PG8_SA(0, 1), cA + hstepA, voffA);
        if (wr == 1) PG8_BAR;
        PG8_WAIT_V(2); PG8_BAR;
        PG8_STAGE_B(PG8_SB(1, 0), cB + kstep, voffB); PG8_STAGE_A(PG8_SA(1, 0), cA + kstep, voffA); PG8_STAGE_B(PG8_SB(1, 1), cB + hstepB + kstep, voffB);
        PG8_WAIT_V(6); PG8_BAR;
    } else {
        PG8_STAGE_B(PG8_SB(0, 0), cB, voffB); PG8_STAGE_A(PG8_SA(0, 0), cA, voffA); PG8_STAGE_B(PG8_SB(0, 1), cB + hstepB, voffB); PG8_STAGE_A(PG8_SA(0, 1), cA + hstepA, voffA);
        if (wr == 1) PG8_BAR;
        PG8_WAIT_V(4); PG8_BAR;
        PG8_STAGE_B(PG8_SB(1, 0), cB + kstep, voffB); PG8_STAGE_A(PG8_SA(1, 0), cA + kstep, voffA); PG8_STAGE_B(PG8_SB(1, 1), cB + hstepB + kstep, voffB);
        PG8_WAIT_V(6); PG8_BAR;
    }
    for (;;) {
        const bool has_next = S.next(ui + 1, nxt);
        const unsigned nA = has_next ? (unsigned)nxt.pm * tstepA + (unsigned)(nxt.pn >> 1) * g.agrp_bytes : cA, nB = has_next ? (unsigned)nxt.pn * tstepB : cB;
        for (int t = 0; t < nt; t += 2) {
            const bool last = (t == nt - 2);
            const unsigned a1 = cA + (unsigned)(t + 1) * kstep;
            const unsigned a2 = last ? nA : cA + (unsigned)(t + 2) * kstep, b2 = last ? nB : cB + (unsigned)(t + 2) * kstep;
            const unsigned a3 = a2 + kstep, b3 = b2 + kstep;
            if (last && has_next) S.a_ready(nxt);
            if constexpr (SP2) {
            PG8_LDB(B0, 0, 0); PG8_LDB(B1, 0, 1); PG8_SCHED; PG8_LDA(At, 0, 0); PG8_STAGE_A(PG8_SA(1, 1), a1 + hstepA, voffA);
            PG8_WAIT_V(8); PG8_WAIT_L(0); PG8_BAR; PG8_MMA(0, 0, At, B0); PG8_MMA(0, 1, At, B1); PG8_BAR; PG8_SCHED;
            PG8_LDA(At, 0, 1); PG8_STAGE_B(PG8_SB(0, 0), b2, voffB); PG8_STAGE_B(PG8_SB(0, 1), b2 + hstepB, voffB); PG8_STAGE_A(PG8_SA(0, 0), a2, voffA);
            PG8_WAIT_V(8); PG8_WAIT_L(0); PG8_BAR; PG8_MMA(1, 0, At, B0); PG8_MMA(1, 1, At, B1); PG8_BAR; PG8_SCHED;
            PG8_LDB(B0, 1, 0); PG8_LDB(B1, 1, 1); PG8_SCHED; PG8_LDA(At, 1, 0); PG8_STAGE_A(PG8_SA(0, 1), a2 + hstepA, voffA);
            PG8_WAIT_V(8); PG8_WAIT_L(0); PG8_BAR; PG8_MMA(0, 0, At, B0); PG8_MMA(0, 1, At, B1); PG8_BAR; PG8_SCHED;
            PG8_LDA(At, 1, 1); PG8_STAGE_B(PG8_SB(1, 0), b3, voffB); PG8_STAGE_B(PG8_SB(1, 1), b3 + hstepB, voffB); PG8_STAGE_A(PG8_SA(1, 0), a3, voffA);
            PG8_WAIT_V(8); PG8_WAIT_L(0); PG8_BAR; PG8_MMA(1, 0, At, B0); PG8_MMA(1, 1, At, B1); PG8_BAR; PG8_SCHED;
            } else {
            PG8_LDB(B0, 0, 0); PG8_SCHED; PG8_LDA(At, 0, 0); PG8_STAGE_A(PG8_SA(1, 1), a1 + hstepA, voffA);
            PG8_WAIT_L(8); PG8_BAR; PG8_WAIT_L(0); PG8_MMA(0, 0, At, B0); PG8_BAR; PG8_SCHED;
            PG8_LDB(B1, 0, 1); PG8_STAGE_B(PG8_SB(0, 0), b2, voffB);
            PG8_BAR; PG8_WAIT_L(0); PG8_MMA(0, 1, At, B1); PG8_BAR;
            PG8_LDA(At, 0, 1); PG8_STAGE_A(PG8_SA(0, 0), a2, voffA);
            PG8_BAR; PG8_WAIT_L(0); PG8_MMA(1, 0, At, B0); PG8_BAR; PG8_SCHED;
            PG8_STAGE_B(PG8_SB(0, 1), b2 + hstepB, voffB);
            PG8_WAIT_V(6); PG8_BAR; PG8_MMA(1, 1, At, B1); PG8_BAR;
            PG8_LDB(B0, 1, 0); PG8_SCHED; PG8_LDA(At, 1, 0); PG8_STAGE_A(PG8_SA(0, 1), a2 + hstepA, voffA);
            PG8_WAIT_L(8); PG8_BAR; PG8_WAIT_L(0); PG8_MMA(0, 0, At, B0); PG8_BAR; PG8_SCHED;
            PG8_LDB(B1, 1, 1); PG8_STAGE_B(PG8_SB(1, 0), b3, voffB);
            PG8_BAR; PG8_WAIT_L(0); PG8_MMA(0, 1, At, B1); PG8_BAR;
            PG8_LDA(At, 1, 1); PG8_STAGE_A(PG8_SA(1, 0), a3, voffA);
            PG8_BAR; PG8_WAIT_L(0); PG8_MMA(1, 0, At, B0); PG8_BAR; PG8_SCHED;
            PG8_STAGE_B(PG8_SB(1, 1), b3 + hstepB, voffB);
            PG8_WAIT_V(6); PG8_BAR; PG8_MMA(1, 1, At, B1); PG8_BAR;
            }
        }
        if constexpr (ALIGN_EPI) { if (wr == 0) PG8_BAR; }
        E(acc, cur, wr, wc, fr, fq); S.done(cur);
        if (!has_next) break;
#pragma unroll
        for (int a = 0; a < 2; ++a)
#pragma unroll
            for (int b = 0; b < 2; ++b)
#pragma unroll
                for (int m = 0; m < 4; ++m)
#pragma unroll
                    for (int n = 0; n < 2; ++n) acc[a][b][m][n] = (f32x4){0.f, 0.f, 0.f, 0.f};
        cur = nxt; cA = nA; cB = nB; ++ui;
        if constexpr (ALIGN_EPI) { if (wr == 1) PG8_BAR; }
    }
    PG8_WAIT_V(0);
    if constexpr (!ALIGN_EPI) { if (wr == 0) PG8_BAR; }
    PG8_BAR;
#undef PG8_SA
#undef PG8_SB
#undef PG8_STAGE_A
#undef PG8_STAGE_B
#undef PG8_LDA
#undef PG8_LDB
#undef PG8_MMA
#undef PG8_WAIT_V
#undef PG8_WAIT_L
#undef PG8_BAR
#undef PG8_SCHED
}
}
#ifndef MK_SEGLEN
#define MK_SEGLEN 1024
#endif
constexpr int NWAVES = 8;
constexpr int BATCH = 2, SEQ = 8192, D = 2048, M = BATCH * SEQ, DFF = 5632, NFF2 = 2 * DFF, NPROJ = 4 * D, NMOD = 6 * D, DEPTH = 4;
constexpr int HEADS = 16, HD = 128, PGD = 512;
constexpr float EPS = 1e-6f;
constexpr int KC = 32, KR = D / KC;
constexpr int NPHASE = 24;

constexpr size_t MiB = 1u << 20;
constexpr size_t WS_CTL = 0, CTL_ZERO_BYTES = 1 * MiB;
constexpr size_t WS_PART = 1 * MiB;
constexpr size_t WS_VEC = 14 * MiB;
constexpr size_t WS_SS = 16 * MiB;
constexpr size_t WS_REC = 18 * MiB;
constexpr size_t WS_WPOOL = 36 * MiB, WS_WHOUT = 40 * MiB, WS_WHIN = 56 * MiB, WS_WFIN = 120 * MiB, WS_WFOUT = 296 * MiB;
constexpr size_t WS_X = 384 * MiB, WS_XG = 512 * MiB, WS_AOP = 576 * MiB, WS_HID = 640 * MiB, WS_PROJ = 816 * MiB, WS_END = 1072 * MiB;
constexpr int V_SHM = 0, V_SHF = V_SHM + DEPTH * 2 * D, V_GM = V_SHF + DEPTH * 2 * D, V_GF = V_GM + DEPTH * 2 * D, V_GATEM = V_GF + DEPTH * 2 * D, V_GATEF = V_GATEM + DEPTH * 2 * D,
              V_LB = V_GATEF + DEPTH * 2 * D, V_BIASP = V_LB + 2 * D, V_BIASF = V_BIASP + 2 * 2 * NPROJ, V_END = V_BIASF + DEPTH * 2 * NFF2;
static_assert((size_t)V_END * 4 <= 2 * MiB, "vec region");
constexpr int CW_TMO = 0, CW_BAR = 4096;

constexpr int RING_OFF = 0, RING_BYTES = 131072;
constexpr int LDSCTL_OFF = RING_BYTES, MISC_OFF = LDSCTL_OFF + 320;
constexpr int LDS_BYTES = 147456;

#define GAS __attribute__((address_space(1)))
#define LAS __attribute__((address_space(3)))
typedef unsigned short bf16;
typedef unsigned v4u __attribute__((ext_vector_type(4)));
typedef unsigned v2u __attribute__((ext_vector_type(2)));
typedef float f32x4 __attribute__((ext_vector_type(4)));
typedef GAS unsigned gu32;
#define RLX_AGENT __ATOMIC_RELAXED, __HIP_MEMORY_SCOPE_AGENT
#define LDS_WAIT() asm volatile("s_waitcnt lgkmcnt(0)" ::: "memory")
#define VM_WAIT() asm volatile("s_waitcnt vmcnt(0)" ::: "memory")
__device__ __forceinline__ unsigned f2bf(float f) { unsigned u = __builtin_bit_cast(unsigned, f); return (u + 0x7fffu + ((u >> 16) & 1u)) >> 16; }
__device__ __forceinline__ unsigned pk2(float lo, float hi) { return f2bf(lo) | (f2bf(hi) << 16); }
__device__ __forceinline__ float bf2f(unsigned short b) { return __builtin_bit_cast(float, (unsigned)b << 16); }
__device__ __forceinline__ float bflo(unsigned w) { return __builtin_bit_cast(float, w << 16); }
__device__ __forceinline__ float bfhi(unsigned w) { return __builtin_bit_cast(float, w & 0xffff0000u); }
typedef _Float16 h2_t __attribute__((ext_vector_type(2)));
typedef float f32x2_t __attribute__((ext_vector_type(2)));
__device__ __forceinline__ unsigned pkh2(float lo, float hi) { const f32x2_t v = {lo, hi}; return __builtin_bit_cast(unsigned, __builtin_convertvector(v, h2_t)); }
__device__ __forceinline__ f32x2_t unph2(unsigned w) { return __builtin_convertvector(__builtin_bit_cast(h2_t, w), f32x2_t); }
__device__ __forceinline__ float sigmoidf_(float v) { return __builtin_amdgcn_rcpf(1.0f + __expf(-v)); }

#define XB_TMO      128
#define XB_XCNT(j)  (256  + 64 * (j))
#define XB_XSUB(j)  (1280 + 64 * (j))
#define XB_XGEN(j)  (2304 + 64 * (j))
#define XB_TOP      3328
#define XB_TOPGEN   3392
#define XCD_BAR_WORDS 3456
#define XB_SPIN_CAP (1u << 18)

__device__ __forceinline__ unsigned xb_ld(unsigned* p)              { return __hip_atomic_load(p, __ATOMIC_RELAXED, __HIP_MEMORY_SCOPE_AGENT); }
__device__ __forceinline__ unsigned xb_add(unsigned* p, unsigned v) { return __hip_atomic_fetch_add(p, v, __ATOMIC_RELAXED, __HIP_MEMORY_SCOPE_AGENT); }
__device__ __forceinline__ unsigned xb_xcc_id() { return (unsigned)__builtin_amdgcn_s_getreg((3 << 11) | 20) & 0xFu; }
#define XB_SPIN(cond, bar) do { unsigned _sp = 0; while (cond) { __builtin_amdgcn_s_sleep(1); \
    if ((++_sp & 255u) == 0u) { if (xb_ld(&(bar)[XB_TMO])) break; if (_sp > XB_SPIN_CAP) { atomicAdd(&(bar)[XB_TMO], 1u); break; } } } } while (0)

struct XcdBarrier { unsigned* bar; unsigned x; volatile LAS unsigned* st; };

__device__ __forceinline__ XcdBarrier xcd_barrier_post(unsigned* bar, volatile LAS unsigned* st) {
    XcdBarrier b; b.bar = bar; b.x = xb_xcc_id(); b.st = st;
    if (threadIdx.x == 0) (void)xb_add(&bar[XB_XCNT(b.x)], 1u);
    return b;
}
__device__ __forceinline__ void xcd_barrier_complete(unsigned* bar, unsigned x, unsigned& nloc, unsigned& nx) {
    const unsigned G = gridDim.x * gridDim.y * gridDim.z;
    unsigned sum, cnt, mine, sp = 0u;
    for (;;) {
        sum = 0u; cnt = 0u; mine = 0u;
#pragma unroll
        for (unsigned j = 0; j < 16; ++j) { const unsigned c = xb_ld(&bar[XB_XCNT(j)]); sum += c; cnt += (c > 0u) ? 1u : 0u; mine = (j == x) ? c : mine; }
        if (sum == G) break;
        __builtin_amdgcn_s_sleep(1);
        if ((++sp & 255u) == 0u) { if (xb_ld(&bar[XB_TMO])) break; if (sp > XB_SPIN_CAP) { atomicAdd(&bar[XB_TMO], 1u); break; } }
    }
    nloc = mine > 0u ? mine : 1u; nx = cnt > 0u ? cnt : 1u;
}
__device__ __forceinline__ void xcd_barrier(const XcdBarrier& b, const int wave) {
    asm volatile("s_waitcnt vmcnt(0)" ::: "memory");
    __syncthreads();
    if (wave == 0 && __builtin_amdgcn_mbcnt_hi(~0u, __builtin_amdgcn_mbcnt_lo(~0u, 0u)) == 0) {
        unsigned* bar = b.bar;
        __builtin_amdgcn_s_waitcnt(0);
        unsigned nloc = b.st[0], nx = b.st[1];
        if (nloc == 0u) { xcd_barrier_complete(bar, b.x, nloc, nx); b.st[0] = nloc; b.st[1] = nx; }
        const unsigned old = xb_add(&bar[XB_XSUB(b.x)], 1u);
        const unsigned gen = old / nloc;
        if (old + 1u == (gen + 1u) * nloc) {
            __builtin_amdgcn_fence(__ATOMIC_RELEASE, "agent");
            asm volatile("s_waitcnt vmcnt(0)" ::: "memory");
            const unsigned og = xb_add(&bar[XB_TOP], 1u);
            const unsigned tg = og / nx;
            if (og + 1u == (tg + 1u) * nx) xb_add(&bar[XB_TOPGEN], 1u);
            else XB_SPIN(xb_ld(&bar[XB_TOPGEN]) == tg, bar);
            __builtin_amdgcn_fence(__ATOMIC_ACQUIRE, "agent");
            xb_add(&bar[XB_XGEN(b.x)], 1u);
            asm volatile("s_waitcnt vmcnt(0)" ::: "memory");
        } else {
            XB_SPIN(xb_ld(&bar[XB_XGEN(b.x)]) == gen, bar);
            __builtin_amdgcn_fence(__ATOMIC_ACQUIRE, "agent");
            asm volatile("s_waitcnt vmcnt(0)" ::: "memory");
        }
    }
    __syncthreads();
}

struct Frame {
    LAS unsigned char* lds;
    int tid, lane, wave, G;
    const float *x, *c, *gmix, *gffn, *wada, *bada, *poolw, *pools, *hwin, *hwout, *hgain, *hlb, *wfin, *wfout, *fgain;
    float* out; unsigned char* ws;
    float* vec;
};
__device__ __forceinline__ int lane_id() { int l = __builtin_amdgcn_mbcnt_hi(~0u, __builtin_amdgcn_mbcnt_lo(~0u, 0u)); asm volatile("" : "+v"(l)); return l; }
__device__ __forceinline__ float wave_sum(float v) {
#pragma unroll
    for (int o = 1; o < 64; o <<= 1) v += __shfl_xor(v, o);
    return v;
}

struct CvtTile { f32x4 w[8]; };
__device__ __forceinline__ void cvt_load(CvtTile& t, const float* W, int N, int k0, int n0_src, int lane) {
#pragma unroll
    for (int i = 0; i < 8; ++i) t.w[i] = *(const GAS f32x4*)(W + (size_t)(k0 + 8 * i + (lane >> 3)) * N + n0_src + 4 * (lane & 7));
}
template <bool BIAS>
__device__ __forceinline__ void cvt_store(const CvtTile& t, bf16* WT, int K, int k0, int n0_dst, LAS float* scr, int lane, const LAS float* shL, int Ktot, float (&bacc)[2][4]) {
#pragma unroll
    for (int i = 0; i < 8; ++i) { LAS float* p = scr + (8 * i + (lane >> 3)) * 33 + 4 * (lane & 7); p[0] = t.w[i].x; p[1] = t.w[i].y; p[2] = t.w[i].z; p[3] = t.w[i].w; }
    LDS_WAIT(); asm volatile("" ::: "memory");
    const int c = lane & 7;
    f32x4 s0a, s0b, s1a, s1b;
    if (BIAS) { s0a = *(const LAS f32x4*)(shL + k0 + 8 * c); s0b = *(const LAS f32x4*)(shL + k0 + 8 * c + 4); s1a = *(const LAS f32x4*)(shL + Ktot + k0 + 8 * c); s1b = *(const LAS f32x4*)(shL + Ktot + k0 + 8 * c + 4); }
#pragma unroll
    for (int j = 0; j < 4; ++j) { const int n = (lane >> 3) + 8 * j; const LAS float* s = scr + (8 * c) * 33 + n;
        const float v0 = s[0 * 33], v1 = s[1 * 33], v2 = s[2 * 33], v3 = s[3 * 33], v4 = s[4 * 33], v5 = s[5 * 33], v6 = s[6 * 33], v7 = s[7 * 33];
        if (BIAS) { bacc[0][j] += (v0 * s0a.x + v1 * s0a.y) + (v2 * s0a.z + v3 * s0a.w) + (v4 * s0b.x + v5 * s0b.y) + (v6 * s0b.z + v7 * s0b.w);
                    bacc[1][j] += (v0 * s1a.x + v1 * s1a.y) + (v2 * s1a.z + v3 * s1a.w) + (v4 * s1b.x + v5 * s1b.y) + (v6 * s1b.z + v7 * s1b.w); }
        v4u o; o.x = pg8::cvt_pk_bf16(v0, v1); o.y = pg8::cvt_pk_bf16(v2, v3); o.z = pg8::cvt_pk_bf16(v4, v5); o.w = pg8::cvt_pk_bf16(v6, v7);
        *(GAS v4u*)(WT + (size_t)(n0_dst + n) * K + k0 + 8 * c) = o; }
    LDS_WAIT(); asm volatile("" ::: "memory");
}
__device__ __forceinline__ void convert_matrix(Frame& F, const float* W, int K, int N, bf16* WT, LAS float* scr, int& itbase) {
    const int gw = blockIdx.x * NWAVES + F.wave, NGW = F.G * NWAVES;
    const int nblk = N / 32, nitems = (K / 64) * nblk;
    int it = (gw - itbase % NGW + NGW) % NGW;
    float dummy[2][4];
    CvtTile cur, nxt;
    if (it < nitems) cvt_load(nxt, W, N, 64 * (it / nblk), 32 * (it % nblk), F.lane);
    for (; it < nitems; it += NGW) {
        cur = nxt; const int itn = it + NGW;
        if (itn < nitems) cvt_load(nxt, W, N, 64 * (itn / nblk), 32 * (itn % nblk), F.lane);
        cvt_store<false>(cur, WT, K, 64 * (it / nblk), 32 * (it % nblk), scr, F.lane, nullptr, 0, dummy);
    }
    itbase += nitems;
}

__device__ __forceinline__ void phase_p0a(Frame& F) {
    const int gw = blockIdx.x * NWAVES + F.wave, NGW = F.G * NWAVES, gt = blockIdx.x * (NWAVES * 64) + F.tid;
    LAS float* condL = (LAS float*)(F.lds + RING_OFF);
    for (int i = F.tid; i < 2 * D; i += NWAVES * 64) { const float cv = F.c[i]; condL[i] = cv * sigmoidf_(cv); }
    __syncthreads();
    float* part = (float*)(F.ws + WS_PART);
    for (int it = gw; it < DEPTH * KC * (NMOD / 256); it += NGW) {
        const int ns = it % (NMOD / 256), kc = (it / (NMOD / 256)) % KC, l = it / ((NMOD / 256) * KC);
        const float* W = F.wada + ((size_t)l * D + (size_t)kc * KR) * NMOD + ns * 256 + F.lane * 4;
        f32x4 a0 = {0.f, 0.f, 0.f, 0.f}, a1 = {0.f, 0.f, 0.f, 0.f};
        for (int k = 0; k < KR; k += 8) {
            f32x4 w[8];
#pragma unroll
            for (int j = 0; j < 8; ++j) w[j] = *(const GAS f32x4*)(W + (size_t)(k + j) * NMOD);
#pragma unroll
            for (int j = 0; j < 8; ++j) { const float c0 = condL[kc * KR + k + j], c1 = condL[D + kc * KR + k + j]; a0 += c0 * w[j]; a1 += c1 * w[j]; }
        }
        *(GAS f32x4*)(part + ((size_t)(kc * DEPTH + l) * 2 + 0) * NMOD + ns * 256 + F.lane * 4) = a0;
        *(GAS f32x4*)(part + ((size_t)(kc * DEPTH + l) * 2 + 1) * NMOD + ns * 256 + F.lane * 4) = a1;
    }
    if (gt < D) {
        const float l0 = F.hlb[gt], l1 = F.hlb[D + gt], l2 = F.hlb[2 * D + gt], l3 = F.hlb[3 * D + gt];
        const float mx = fmaxf(fmaxf(l0, l1), fmaxf(l2, l3));
        const float e0 = __expf(l0 - mx), e1 = __expf(l1 - mx), e2 = __expf(l2 - mx), e3 = __expf(l3 - mx), inv = 1.0f / (e0 + e1 + e2 + e3);
        F.vec[V_LB + gt] = e1 * inv; F.vec[V_LB + D + gt] = (e1 + e2 + e3) * inv;
    }
    float* ss = (float*)(F.ws + WS_SS);
    for (int m = gw; m < M; m += NGW) {
        const GAS f32x4* xr = (const GAS f32x4*)(F.x + (size_t)m * D) + F.lane; float s = 0.f;
#pragma unroll
        for (int j = 0; j < 8; ++j) { const f32x4 v = xr[64 * j]; s += (v.x * v.x + v.y * v.y) + (v.z * v.z + v.w * v.w); }
        s = wave_sum(s);
        if (F.lane < 32) ss[(size_t)m * 32 + F.lane] = (F.lane == 0) ? s : 0.f;
    }
    __syncthreads();
    LAS float* scr = (LAS float*)(F.lds + RING_OFF + F.wave * 16384);
    int itbase = 0;
    for (int j = 0; j < 8; ++j) convert_matrix(F, F.poolw + (size_t)j * PGD * PGD, PGD, PGD, (bf16*)(F.ws + WS_WPOOL) + (size_t)j * PGD * PGD, scr, itbase);
    for (int j = 0; j < 2; ++j) convert_matrix(F, F.hwout + (size_t)j * D * D, D, D, (bf16*)(F.ws + WS_WHOUT) + (size_t)j * D * D, scr, itbase);
    for (int j = 0; j < DEPTH; ++j) convert_matrix(F, F.wfout + (size_t)j * DFF * D, DFF, D, (bf16*)(F.ws + WS_WFOUT) + (size_t)j * DFF * D, scr, itbase);
}
__device__ __forceinline__ void phase_p0b(Frame& F) {
    const int gt = blockIdx.x * (NWAVES * 64) + F.tid;
    if (gt >= DEPTH * 2 * (D / 4) * 6) return;
    const int cq = gt % (D / 4), r = gt / (D / 4), j = r % 6, b = (r / 6) % 2, l = r / 12, col = cq * 4;
    const float* part = (const float*)(F.ws + WS_PART);
    f32x4 s = *(const GAS f32x4*)(F.bada + (size_t)l * NMOD + j * D + col);
    f32x4 pv[KC];
#pragma unroll
    for (int kc = 0; kc < KC; ++kc) pv[kc] = *(const GAS f32x4*)(part + ((size_t)(kc * DEPTH + l) * 2 + b) * NMOD + j * D + col);
#pragma unroll
    for (int kc = 0; kc < KC; ++kc) s += pv[kc];
    const int vo = (l * 2 + b) * D + col;
    if (j == 0) *(GAS f32x4*)(F.vec + V_SHM + vo) = s;
    else if (j == 1) *(GAS f32x4*)(F.vec + V_GM + vo) = *(const GAS f32x4*)(F.gmix + (size_t)l * D + col) * (1.0f + s);
    else if (j == 2) { if ((l & 1) == 0) s = s * *(const GAS f32x4*)(F.pools + (size_t)(l >> 1) * D + col); *(GAS f32x4*)(F.vec + V_GATEM + vo) = s; }
    else if (j == 3) *(GAS f32x4*)(F.vec + V_SHF + vo) = s;
    else if (j == 4) *(GAS f32x4*)(F.vec + V_GF + vo) = *(const GAS f32x4*)(F.gffn + (size_t)l * D + col) * (1.0f + s);
    else *(GAS f32x4*)(F.vec + V_GATEF + vo) = s;
}
__device__ __forceinline__ void phase_p0c(Frame& F) {
    constexpr int NB_H = NPROJ / 256, NB_F = NFF2 / 256;
    constexpr int NITEMS = 2 * NB_H + DEPTH * NB_F;
    LAS float* shL = (LAS float*)(F.lds + RING_OFF);
    LAS float* scr = (LAS float*)(F.lds + RING_OFF + 16384 + F.wave * 12288);
    for (int bi = blockIdx.x; bi < NITEMS; bi += F.G) {
        const bool is_h = bi < 2 * NB_H;
        const int mi = is_h ? bi / NB_H : (bi - 2 * NB_H) / NB_F, grp = is_h ? bi % NB_H : (bi - 2 * NB_H) % NB_F;
        const int layer = is_h ? 2 * mi + 1 : mi;
        const int N = is_h ? NPROJ : NFF2;
        const float* W = is_h ? F.hwin + (size_t)mi * D * NPROJ : F.wfin + (size_t)mi * D * NFF2;
        bf16* WT = is_h ? (bf16*)(F.ws + WS_WHIN) + (size_t)mi * NPROJ * D : (bf16*)(F.ws + WS_WFIN) + (size_t)mi * NFF2 * D;
        const float* shv = F.vec + (is_h ? V_SHM : V_SHF) + (size_t)layer * 2 * D;
        float* biasv = F.vec + (is_h ? V_BIASP + (size_t)mi * 2 * NPROJ : V_BIASF + (size_t)mi * 2 * NFF2);
        __syncthreads();
        for (int i = F.tid; i < 2 * D; i += NWAVES * 64) shL[i] = shv[i];
        __syncthreads();
        const int n0_dst = grp * 256 + F.wave * 32;
        int n0_src = n0_dst;
        if (!is_h) { const int pn = n0_dst / 256, within = n0_dst % 256, bj = within / 128, j = within % 128; n0_src = bj * DFF + pn * 128 + j; }
        float bacc[2][4];
#pragma unroll
        for (int q = 0; q < 2; ++q)
#pragma unroll
            for (int jj = 0; jj < 4; ++jj) bacc[q][jj] = 0.f;
        CvtTile cur, nxt, nx2;
        cvt_load(nxt, W, N, 0, n0_src, F.lane); cvt_load(nx2, W, N, 64, n0_src, F.lane);
        for (int kb = 0; kb < D / 64; ++kb) {
            cur = nxt; nxt = nx2;
            if (kb + 2 < D / 64) cvt_load(nx2, W, N, 64 * (kb + 2), n0_src, F.lane);
            cvt_store<true>(cur, WT, D, 64 * kb, n0_dst, scr, F.lane, shL, D, bacc);
        }
#pragma unroll
        for (int q = 0; q < 2; ++q)
#pragma unroll
            for (int jj = 0; jj < 4; ++jj) { float v = bacc[q][jj]; v += __shfl_xor(v, 1); v += __shfl_xor(v, 2); v += __shfl_xor(v, 4);
                if ((F.lane & 7) == 0) biasv[q * N + n0_dst + (F.lane >> 3) + 8 * jj] = v; }
    }
}
template <bool XF32>
__device__ __forceinline__ void load_x8(const void* xsrc, size_t eoff, float (&v)[8]) {
    if (XF32) { const f32x4 a = *(const GAS f32x4*)((const float*)xsrc + eoff), b = *(const GAS f32x4*)((const float*)xsrc + eoff + 4);
        v[0] = a.x; v[1] = a.y; v[2] = a.z; v[3] = a.w; v[4] = b.x; v[5] = b.y; v[6] = b.z; v[7] = b.w; }
    else { const v4u a = *(const GAS v4u*)((const unsigned short*)xsrc + eoff); const f32x2_t p0 = unph2(a.x), p1 = unph2(a.y), p2 = unph2(a.z), p3 = unph2(a.w);
        v[0] = p0.x; v[1] = p0.y; v[2] = p1.x; v[3] = p1.y; v[4] = p2.x; v[5] = p2.y; v[6] = p3.x; v[7] = p3.y; }
}
template <bool XF32>
__device__ __forceinline__ void phase_poolprep(Frame& F, int layer, const void* xsrc) {
    LAS float* rs = (LAS float*)(F.lds + RING_OFF);
    const float* ss = (const float*)(F.ws + WS_SS);
    bf16* dst = (bf16*)(F.ws + WS_AOP);
    for (int ts = blockIdx.x; ts < M / 64; ts += F.G) {
        const int r0 = ts * 64, b = r0 / SEQ, t0 = r0 % SEQ;
        __syncthreads();
        if (F.tid < 80) { const int row = r0 - 16 + F.tid; float v = 0.f;
            if (t0 - 16 + F.tid >= 0) { float s = 0.f; for (int j = 0; j < 32; ++j) s += ss[(size_t)row * 32 + j]; v = rsqrtf(s * (1.0f / D) + EPS); }
            rs[F.tid] = v; }
        __syncthreads();
        const int half = F.tid >> 8, col = (F.tid & 255) * 8, g = col >> 9, w = 2 << g, rb = r0 + half * 32, tb = t0 + half * 32, ib = 16 + half * 32;
        float gm[8], sh[8], S[8], xv[8];
        { const f32x4 a = *(const GAS f32x4*)(F.vec + V_GM + (layer * 2 + b) * D + col), c = *(const GAS f32x4*)(F.vec + V_GM + (layer * 2 + b) * D + col + 4);
          gm[0] = a.x; gm[1] = a.y; gm[2] = a.z; gm[3] = a.w; gm[4] = c.x; gm[5] = c.y; gm[6] = c.z; gm[7] = c.w; }
        { const f32x4 a = *(const GAS f32x4*)(F.vec + V_SHM + (layer * 2 + b) * D + col), c = *(const GAS f32x4*)(F.vec + V_SHM + (layer * 2 + b) * D + col + 4);
          sh[0] = a.x; sh[1] = a.y; sh[2] = a.z; sh[3] = a.w; sh[4] = c.x; sh[5] = c.y; sh[6] = c.z; sh[7] = c.w; }
#pragma unroll
        for (int e = 0; e < 8; ++e) S[e] = 0.f;
        for (int j = 1; j < w; ++j) { if (tb - j >= 0) { load_x8<XF32>(xsrc, (size_t)(rb - j) * D + col, xv); const float r = rs[ib - j];
#pragma unroll
            for (int e = 0; e < 8; ++e) S[e] += xv[e] * r * gm[e] + sh[e]; } }
#pragma unroll 4
        for (int i = 0; i < 32; ++i) {
            const int t = tb + i;
            load_x8<XF32>(xsrc, (size_t)(rb + i) * D + col, xv);
            const float r = rs[ib + i]; const float inv = __builtin_amdgcn_rcpf((float)((t + 1 < w) ? (t + 1) : w));
            float dv[8];
#pragma unroll
            for (int e = 0; e < 8; ++e) { const float h = xv[e] * r * gm[e] + sh[e]; S[e] += h; dv[e] = S[e] * inv - h; }
            v4u o; o.x = pg8::cvt_pk_bf16(dv[0], dv[1]); o.y = pg8::cvt_pk_bf16(dv[2], dv[3]); o.z = pg8::cvt_pk_bf16(dv[4], dv[5]); o.w = pg8::cvt_pk_bf16(dv[6], dv[7]);
            *(GAS v4u*)(dst + (size_t)(rb + i) * D + col) = o;
            if (t - w + 1 >= 0) { load_x8<XF32>(xsrc, (size_t)(rb + i - w + 1) * D + col, xv); const float ro = rs[ib + i - w + 1];
#pragma unroll
                for (int e = 0; e < 8; ++e) S[e] -= xv[e] * ro * gm[e] + sh[e]; }
        }
    }
}
typedef short bf16x8_t __attribute__((ext_vector_type(8)));
__device__ __forceinline__ bf16x8_t frag2(const LAS unsigned char* p0, const LAS unsigned char* p1) {
    const v2u a = *(const LAS v2u*)p0, b = *(const LAS v2u*)p1; v4u r; r.x = a.x; r.y = a.y; r.z = b.x; r.w = b.y; return __builtin_bit_cast(bf16x8_t, r);
}
typedef short s16x4_t __attribute__((ext_vector_type(4)));
__device__ __forceinline__ bf16x8_t fragtr(const LAS unsigned char* p0, const LAS unsigned char* p1) {
    const s16x4_t a = __builtin_amdgcn_ds_read_tr16_b64_v4i16((LAS s16x4_t*)p0), b = __builtin_amdgcn_ds_read_tr16_b64_v4i16((LAS s16x4_t*)p1);
    const v2u ua = __builtin_bit_cast(v2u, a), ub = __builtin_bit_cast(v2u, b); v4u r; r.x = ua.x; r.y = ua.y; r.z = ub.x; r.w = ub.y; return __builtin_bit_cast(bf16x8_t, r);
}
__device__ __forceinline__ bf16x8_t packf(const f32x4 lo, const f32x4 hi) {
    v4u r; r.x = pg8::cvt_pk_bf16(lo.x, lo.y); r.y = pg8::cvt_pk_bf16(lo.z, lo.w); r.z = pg8::cvt_pk_bf16(hi.x, hi.y); r.w = pg8::cvt_pk_bf16(hi.z, hi.w); return __builtin_bit_cast(bf16x8_t, r);
}
template <int CTRL, int ROWMASK> __device__ __forceinline__ float dpp_f(float v) { return __builtin_bit_cast(float, __builtin_amdgcn_update_dpp(0, __builtin_bit_cast(int, v), CTRL, ROWMASK, 0xF, false)); }
namespace recl { constexpr int C = 32, QS = 272, TS = 288, OSS = 528;
    constexpr int DEC = 0, QH = 512, KT = QH + 32 * QS, KH = KT + 32 * QS, V = KH + 32 * TS, OS = V + 32 * TS, SET = OS + 32 * OSS; }
template <bool P2>
__device__ __forceinline__ void rec_prep(LAS unsigned char* lds, const v4u cq, const v4u clf, const v4u cv, const int lane, const int pt, const int pd8, float (&btot)[8]) {
    using namespace recl;
    float lf[8], x[8], bend[8];
    lf[0] = bflo(clf.x); lf[1] = bfhi(clf.x); lf[2] = bflo(clf.y); lf[3] = bfhi(clf.y); lf[4] = bflo(clf.z); lf[5] = bfhi(clf.z); lf[6] = bflo(clf.w); lf[7] = bfhi(clf.w);
#pragma unroll
    for (int e = 0; e < 8; ++e) { float xx = lf[e];
        xx += dpp_f<0x111, 0xF>(xx); xx += dpp_f<0x112, 0xF>(xx); xx += dpp_f<0x114, 0xF>(xx); xx += dpp_f<0x118, 0xF>(xx); xx += dpp_f<0x142, 0xA>(xx);
        x[e] = xx; const float e0v = __builtin_bit_cast(float, __builtin_amdgcn_readlane(__builtin_bit_cast(int, xx), 31)), e1v = __builtin_bit_cast(float, __builtin_amdgcn_readlane(__builtin_bit_cast(int, xx), 63));
        bend[e] = (lane < 32) ? e0v : e1v; }
    float qh[8], kt[8], kh[8];
    { float qq[8];
      qq[0] = bflo(cq.x); qq[1] = bfhi(cq.x); qq[2] = bflo(cq.y); qq[3] = bfhi(cq.y); qq[4] = bflo(cq.z); qq[5] = bfhi(cq.z); qq[6] = bflo(cq.w); qq[7] = bfhi(cq.w);
#pragma unroll
      for (int e = 0; e < 8; ++e) { const float bb = x[e], k = 1.0f - __expf(lf[e]);
          kh[e] = k * __expf(bend[e] - bb);
          if (P2) { qh[e] = qq[e] * __expf(bb); kt[e] = k * __expf(-bb); } else { qh[e] = 0.f; kt[e] = 0.f; btot[e] += bend[e]; } } }
    if (P2) {
        v4u wq, wk; wq.x = pg8::cvt_pk_bf16(qh[0], qh[1]); wq.y = pg8::cvt_pk_bf16(qh[2], qh[3]); wq.z = pg8::cvt_pk_bf16(qh[4], qh[5]); wq.w = pg8::cvt_pk_bf16(qh[6], qh[7]);
        wk.x = pg8::cvt_pk_bf16(kt[0], kt[1]); wk.y = pg8::cvt_pk_bf16(kt[2], kt[3]); wk.z = pg8::cvt_pk_bf16(kt[4], kt[5]); wk.w = pg8::cvt_pk_bf16(kt[6], kt[7]);
        *(LAS v4u*)(lds + QH + pt * QS + pd8 * 2) = wq; *(LAS v4u*)(lds + KT + pt * QS + pd8 * 2) = wk;
    }
    { v4u wh; wh.x = pg8::cvt_pk_bf16(kh[0], kh[1]); wh.y = pg8::cvt_pk_bf16(kh[2], kh[3]); wh.z = pg8::cvt_pk_bf16(kh[4], kh[5]); wh.w = pg8::cvt_pk_bf16(kh[6], kh[7]);
      *(LAS v4u*)(lds + KH + pt * TS + pd8 * 2) = wh; *(LAS v4u*)(lds + V + pt * TS + pd8 * 2) = cv; }
    if (pt == 31) { *(LAS f32x4*)(lds + DEC + pd8 * 4) = (f32x4){__expf(bend[0]), __expf(bend[1]), __expf(bend[2]), __expf(bend[3])};
                    *(LAS f32x4*)(lds + DEC + (pd8 + 4) * 4) = (f32x4){__expf(bend[4]), __expf(bend[5]), __expf(bend[6]), __expf(bend[7])}; }
}
template <bool P2, int RX = 0>
__device__ __forceinline__ void phase_rec(Frame& F, int j) {
    using namespace recl;
    constexpr int SEGLEN = MK_SEGLEN, NCH = SEGLEN / C, NSEG = SEQ / SEGLEN;
    static_assert(2 * SET <= RING_BYTES, "rec LDS");
    const int item = blockIdx.x; if (item >= BATCH * HEADS * NSEG) return;
    const int seq = item / NSEG, p = item % NSEG, b = seq >> 4, h = seq & 15;
    if (!P2 && p == NSEG - 1) return;
    LAS unsigned char* lds0 = F.lds + RING_OFF;
    const int tid = F.tid, lane = F.lane, w = F.wave, fr = lane & 15, g = lane >> 4;
    const int t = tid >> 4, d8 = (tid & 15) * 8;
    const int pt = lane & 31, pd8 = 16 * w + 8 * (lane >> 5);
    const bf16* Q = (const bf16*)(F.ws + WS_PROJ); const bf16* LF = Q + (size_t)M * D; const bf16* V_ = LF + (size_t)M * D; const bf16* Gt = V_ + (size_t)M * D;
    bf16* O = (bf16*)(F.ws + WS_AOP);
    float* Lst = (float*)(F.ws + WS_REC); float* DT = (float*)(F.ws + WS_REC + 16 * MiB);
    const size_t rowb = (size_t)b * SEQ + (size_t)p * SEGLEN;
    const size_t e0 = (rowb + t) * D + h * HD + d8, pe0 = (rowb + pt) * D + h * HD + pd8;
    f32x4 S[8];
#pragma unroll
    for (int i = 0; i < 8; ++i) S[i] = (f32x4){0.f, 0.f, 0.f, 0.f};
    float btot[8];
#pragma unroll
    for (int e = 0; e < 8; ++e) btot[e] = 0.f;
    if (P2) {
        for (int pp = 0; pp < p; ++pp) {
            const int it2 = seq * NSEG + pp;
#pragma unroll
            for (int dt = 0; dt < 8; ++dt) {
                const f32x4 dc = *(const GAS f32x4*)(DT + (size_t)it2 * HD + 16 * dt + 4 * g);
                const f32x4 lv = *(const GAS f32x4*)(Lst + ((((size_t)it2 * 8 + w) * 8 + dt) * 64 + lane) * 4);
                S[dt] = S[dt] * dc + lv;
            }
        }
    }
    f32x4 ga = {0.f, 0.f, 0.f, 0.f}, gb = ga;
    if (P2) { ga = *(const GAS f32x4*)(F.hgain + (size_t)j * D + h * HD + d8); gb = *(const GAS f32x4*)(F.hgain + (size_t)j * D + h * HD + d8 + 4); }
    const v4u z4u = {0u, 0u, 0u, 0u};
    { const v4u q0 = P2 ? *(const GAS v4u*)(Q + pe0) : z4u, l0 = *(const GAS v4u*)(LF + pe0), v0 = *(const GAS v4u*)(V_ + pe0);
      rec_prep<P2>(lds0, q0, l0, v0, lane, pt, pd8, btot); }
    v4u nq = z4u, nlf = z4u, nv = z4u;
    if (NCH > 1) { const size_t adv = (size_t)C * D; nlf = *(const GAS v4u*)(LF + pe0 + adv); nv = *(const GAS v4u*)(V_ + pe0 + adv); if (P2) nq = *(const GAS v4u*)(Q + pe0 + adv); }
    __syncthreads();
    for (int c = 0; c < NCH; ++c) {
        LAS unsigned char* lds = lds0 + (c & 1) * SET;
        LAS unsigned char* ldn = lds0 + ((c + 1) & 1) * SET;
        v4u cg = z4u; if (P2) cg = *(const GAS v4u*)(Gt + e0 + (size_t)c * C * D);
        const v4u cq = nq, clf = nlf, cv = nv;
        if (c + 2 < NCH) { const size_t adv = (size_t)(c + 2) * C * D;
            nlf = *(const GAS v4u*)(LF + pe0 + adv); nv = *(const GAS v4u*)(V_ + pe0 + adv); if (P2) nq = *(const GAS v4u*)(Q + pe0 + adv); }
        if (c + 1 < NCH) rec_prep<P2>(ldn, cq, clf, cv, lane, pt, pd8, btot);
        if (!(RX & 1)) {
        const int trq = fr >> 2, trp = fr & 3;
        const bf16x8_t vf = fragtr(lds + V + (4 * g + trq) * TS + (16 * w + 4 * trp) * 2, lds + V + (16 + 4 * g + trq) * TS + (16 * w + 4 * trp) * 2);
        if (P2) {
            bf16x8_t qf[2][4];
#pragma unroll
            for (int tt = 0; tt < 2; ++tt)
#pragma unroll
                for (int ks = 0; ks < 4; ++ks) qf[tt][ks] = frag2(lds + QH + (16 * tt + fr) * QS + (32 * ks + 4 * g) * 2, lds + QH + (16 * tt + fr) * QS + (32 * ks + 16 + 4 * g) * 2);
            f32x4 at0 = {0.f, 0.f, 0.f, 0.f}, at1 = at0, at2 = at0, o0 = at0, o1 = at0;
#pragma unroll
            for (int ks = 0; ks < 4; ++ks) { const bf16x8_t sf = packf(S[2 * ks], S[2 * ks + 1]);
                o0 = __builtin_amdgcn_mfma_f32_16x16x32_bf16(qf[0][ks], sf, o0, 0, 0, 0);
                o1 = __builtin_amdgcn_mfma_f32_16x16x32_bf16(qf[1][ks], sf, o1, 0, 0, 0); }
#pragma unroll
            for (int ks = 0; ks < 4; ++ks) {
                const bf16x8_t k0 = frag2(lds + KT + fr * QS + (32 * ks + 4 * g) * 2, lds + KT + fr * QS + (32 * ks + 16 + 4 * g) * 2);
                const bf16x8_t k1 = frag2(lds + KT + (16 + fr) * QS + (32 * ks + 4 * g) * 2, lds + KT + (16 + fr) * QS + (32 * ks + 16 + 4 * g) * 2);
                at0 = __builtin_amdgcn_mfma_f32_16x16x32_bf16(k0, qf[0][ks], at0, 0, 0, 0);
                at1 = __builtin_amdgcn_mfma_f32_16x16x32_bf16(k0, qf[1][ks], at1, 0, 0, 0);
                at2 = __builtin_amdgcn_mfma_f32_16x16x32_bf16(k1, qf[1][ks], at2, 0, 0, 0);
            }
#pragma unroll
            for (int r = 0; r < 4; ++r) { const bool keep = (4 * g + r) <= fr; at0[r] = keep ? at0[r] : 0.f; at2[r] = keep ? at2[r] : 0.f; }
            const f32x4 z4 = {0.f, 0.f, 0.f, 0.f};
            const bf16x8_t af0 = packf(at0, z4), af1 = packf(at1, at2);
            o0 = __builtin_amdgcn_mfma_f32_16x16x32_bf16(af0, vf, o0, 0, 0, 0);
            o1 = __builtin_amdgcn_mfma_f32_16x16x32_bf16(af1, vf, o1, 0, 0, 0);
#pragma unroll
            for (int r = 0; r < 4; ++r) { *(LAS float*)(lds + OS + (4 * g + r) * OSS + (16 * w + fr) * 4) = o0[r]; *(LAS float*)(lds + OS + (16 + 4 * g + r) * OSS + (16 * w + fr) * 4) = o1[r]; }
        }
#pragma unroll
        for (int dt = 0; dt < 8; ++dt) {
            const bf16x8_t hf = fragtr(lds + KH + (4 * g + trq) * TS + (16 * dt + 4 * trp) * 2, lds + KH + (16 + 4 * g + trq) * TS + (16 * dt + 4 * trp) * 2);
            const f32x4 dc = *(const LAS f32x4*)(lds + DEC + (16 * dt + 4 * g) * 4);
            S[dt] = __builtin_amdgcn_mfma_f32_16x16x32_bf16(hf, vf, S[dt] * dc, 0, 0, 0);
        }
        }
        __syncthreads();
        if (P2 && !(RX & 4)) {
            const f32x4 oa = *(const LAS f32x4*)(lds + OS + t * OSS + d8 * 4), ob = *(const LAS f32x4*)(lds + OS + t * OSS + (d8 + 4) * 4);
            float sq = (oa.x * oa.x + oa.y * oa.y) + (oa.z * oa.z + oa.w * oa.w) + (ob.x * ob.x + ob.y * ob.y) + (ob.z * ob.z + ob.w * ob.w);
            sq += __shfl_xor(sq, 1); sq += __shfl_xor(sq, 2); sq += __shfl_xor(sq, 4); sq += __shfl_xor(sq, 8);
            const float rstd = rsqrtf(sq * (1.0f / HD) + EPS);
            const float r0 = oa.x * rstd * ga.x * bflo(cg.x), r1 = oa.y * rstd * ga.y * bfhi(cg.x), r2 = oa.z * rstd * ga.z * bflo(cg.y), r3 = oa.w * rstd * ga.w * bfhi(cg.y);
            const float r4 = ob.x * rstd * gb.x * bflo(cg.z), r5 = ob.y * rstd * gb.y * bfhi(cg.z), r6 = ob.z * rstd * gb.z * bflo(cg.w), r7 = ob.w * rstd * gb.w * bfhi(cg.w);
            v4u wo; wo.x = pg8::cvt_pk_bf16(r0, r1); wo.y = pg8::cvt_pk_bf16(r2, r3); wo.z = pg8::cvt_pk_bf16(r4, r5); wo.w = pg8::cvt_pk_bf16(r6, r7);
            *(GAS v4u*)(O + e0 + (size_t)c * C * D) = wo;
        }
    }
    if (!P2) {
#pragma unroll
        for (int dt = 0; dt < 8; ++dt) *(GAS f32x4*)(Lst + ((((size_t)item * 8 + w) * 8 + dt) * 64 + lane) * 4) = S[dt];
        if (pt == 0) {
#pragma unroll
            for (int e = 0; e < 8; ++e) DT[(size_t)item * HD + pd8 + e] = __expf(btot[e]);
        }
    }
}
__device__ __forceinline__ void phase_final(Frame& F) {
    const int gw = blockIdx.x * NWAVES + F.wave, NGW = F.G * NWAVES;
    const unsigned short* X = (const unsigned short*)(F.ws + WS_X); const float* ss = (const float*)(F.ws + WS_SS);
    v4u nx[4]; float ns = 0.f;
    if (gw < M) {
#pragma unroll
        for (int j = 0; j < 4; ++j) nx[j] = *((const GAS v4u*)(X + (size_t)gw * D) + F.lane + 64 * j);
        ns = (F.lane < 32) ? ss[(size_t)gw * 32 + F.lane] : 0.f; }
    for (int m = gw; m < M; m += NGW) {
        v4u cx[4];
#pragma unroll
        for (int j = 0; j < 4; ++j) cx[j] = nx[j];
        const float cs = ns; const int mn = m + NGW;
        if (mn < M) {
#pragma unroll
            for (int j = 0; j < 4; ++j) nx[j] = *((const GAS v4u*)(X + (size_t)mn * D) + F.lane + 64 * j);
            ns = (F.lane < 32) ? ss[(size_t)mn * 32 + F.lane] : 0.f; }
        const float rstd = rsqrtf(wave_sum(cs) * (1.0f / D) + EPS);
        GAS f32x4* orow = (GAS f32x4*)(F.out + (size_t)m * D) + 2 * F.lane; const GAS f32x4* gr = (const GAS f32x4*)F.fgain + 2 * F.lane;
#pragma unroll
        for (int j = 0; j < 4; ++j) { const f32x2_t p0 = unph2(cx[j].x), p1 = unph2(cx[j].y), p2 = unph2(cx[j].z), p3 = unph2(cx[j].w);
            orow[128 * j] = (f32x4){p0.x, p0.y, p1.x, p1.y} * rstd * gr[128 * j]; orow[128 * j + 1] = (f32x4){p2.x, p2.y, p3.x, p3.y} * rstd * gr[128 * j + 1]; }
    }
}

__device__ __forceinline__ float row_rstd(const float* ss, int row, int fq) {
    const f32x4 a = *(const GAS f32x4*)(ss + (size_t)row * 32 + fq * 8), b = *(const GAS f32x4*)(ss + (size_t)row * 32 + fq * 8 + 4);
    float s = ((a.x + a.y) + (a.z + a.w)) + ((b.x + b.y) + (b.z + b.w));
    s += __shfl_xor(s, 16); s += __shfl_xor(s, 32);
    return rsqrtf(s * (1.0f / D) + EPS);
}
__device__ __forceinline__ void swap8(bool lo, const v4u& a0, const v4u& a1, v4u& s1, v4u& s2) {
    v4u snd, rcv; snd.x = lo ? a1.x : a0.x; snd.y = lo ? a1.y : a0.y; snd.z = lo ? a1.z : a0.z; snd.w = lo ? a1.w : a0.w;
    rcv.x = (unsigned)__builtin_amdgcn_update_dpp(0, (int)snd.x, 0x128, 0xf, 0xf, false); rcv.y = (unsigned)__builtin_amdgcn_update_dpp(0, (int)snd.y, 0x128, 0xf, 0xf, false);
    rcv.z = (unsigned)__builtin_amdgcn_update_dpp(0, (int)snd.z, 0x128, 0xf, 0xf, false); rcv.w = (unsigned)__builtin_amdgcn_update_dpp(0, (int)snd.w, 0x128, 0xf, 0xf, false);
    s1.x = lo ? a0.x : rcv.x; s1.y = lo ? a0.y : rcv.y; s1.z = lo ? a0.z : rcv.z; s1.w = lo ? a0.w : rcv.w;
    s2.x = lo ? rcv.x : a1.x; s2.y = lo ? rcv.y : a1.y; s2.z = lo ? rcv.z : a1.z; s2.w = lo ? rcv.w : a1.w;
}
template <bool XF32, bool WXG = true> struct EpiResid {
    static constexpr bool PERM = true; static constexpr bool BJ32 = true;
    const void* xin; void* xr; bf16* xg; float* ss; const float* gate; const float* gnext;
    __device__ __forceinline__ void operator()(const pg8::f32x4 (&acc)[2][2][4][2], const pg8::Unit& u, int wr, int wc, int fr, int fq) const {
        const int b = u.pm >> 5, row0 = u.pm * 256 + wr * 64 + fr, col0 = u.pn * 256 + wc * 64 + 8 * fq;
        f32x4 gt[2][2], gn[2][2];
#pragma unroll
        for (int bj = 0; bj < 2; ++bj)
#pragma unroll
            for (int n = 0; n < 2; ++n) { gt[bj][n] = *(const GAS f32x4*)(gate + b * D + col0 + bj * 32 + 4 * n); gn[bj][n] = *(const GAS f32x4*)(gnext + b * D + col0 + bj * 32 + 4 * n); }
        const bool lo = fr < 8;
        const int srow = (fr & 7) - fr, scol = lo ? 0 : 32;
#pragma unroll
        for (int ai = 0; ai < 2; ++ai)
#pragma unroll
            for (int m = 0; m < 4; ++m) {
                const int row = row0 + ai * 128 + m * 16; const size_t ro = (size_t)row * D + col0; float sq = 0.f;
                v4u wx[2], wg[2];
#pragma unroll
                for (int bj = 0; bj < 2; ++bj) {
                    f32x4 x0, x1;
                    if (XF32) { x0 = *(const GAS f32x4*)((const float*)xin + ro + bj * 32); x1 = *(const GAS f32x4*)((const float*)xin + ro + bj * 32 + 4); }
                    else { const v4u xb = *(const GAS v4u*)((const unsigned short*)xin + ro + bj * 32); const f32x2_t p0 = unph2(xb.x), p1 = unph2(xb.y), p2 = unph2(xb.z), p3 = unph2(xb.w);
                        x0 = (f32x4){p0.x, p0.y, p1.x, p1.y}; x1 = (f32x4){p2.x, p2.y, p3.x, p3.y}; }
                    const f32x4 v0 = x0 + gt[bj][0] * acc[ai][bj][m][0], v1 = x1 + gt[bj][1] * acc[ai][bj][m][1];
                    wx[bj].x = pkh2(v0.x, v0.y); wx[bj].y = pkh2(v0.z, v0.w); wx[bj].z = pkh2(v1.x, v1.y); wx[bj].w = pkh2(v1.z, v1.w);
                    sq += (v0.x * v0.x + v0.y * v0.y) + (v0.z * v0.z + v0.w * v0.w) + (v1.x * v1.x + v1.y * v1.y) + (v1.z * v1.z + v1.w * v1.w);
                    if (WXG) { const f32x4 g0 = v0 * gn[bj][0], g1 = v1 * gn[bj][1];
                        wg[bj].x = pg8::cvt_pk_bf16(g0.x, g0.y); wg[bj].y = pg8::cvt_pk_bf16(g0.z, g0.w); wg[bj].z = pg8::cvt_pk_bf16(g1.x, g1.y); wg[bj].w = pg8::cvt_pk_bf16(g1.z, g1.w); }
                }
                const size_t so = (size_t)(row + srow) * D + col0 + scol;
                { v4u s1, s2; swap8(lo, wx[0], wx[1], s1, s2);
                    __builtin_nontemporal_store(s1, (GAS v4u*)((unsigned short*)xr + so)); __builtin_nontemporal_store(s2, (GAS v4u*)((unsigned short*)xr + so + 8 * D)); }
                if (WXG) { v4u s1, s2; swap8(lo, wg[0], wg[1], s1, s2); *(GAS v4u*)(xg + so) = s1; *(GAS v4u*)(xg + so + 8 * D) = s2; }
                sq += __shfl_xor(sq, 16); sq += __shfl_xor(sq, 32);
                if (fq == 0) ss[(size_t)row * 32 + u.pn * 4 + wc] = sq;
            }
    }
};
constexpr int RS_OFF = RING_BYTES + 1024;
__device__ __forceinline__ void phase_row_rstd(Frame& F, const float* ss, int pm) {
    if (F.tid < 256) { const float* p = ss + ((size_t)pm * 256 + F.tid) * 32; float s = 0.f;
#pragma unroll
        for (int q = 0; q < 8; ++q) { const f32x4 a = *(const GAS f32x4*)(p + 4 * q); s += (a.x + a.y) + (a.z + a.w); }
        ((LAS float*)(F.lds + RS_OFF))[F.tid] = rsqrtf(s * (1.0f / D) + EPS); }
    __syncthreads();
}
struct EpiSwiglu {
    static constexpr bool PERM = true; static constexpr bool BJ32 = false;
    const LAS float* rs; const float* bias; bf16* hid;
    __device__ __forceinline__ void operator()(const pg8::f32x4 (&acc)[2][2][4][2], const pg8::Unit& u, int wr, int wc, int fr, int fq) const {
        const int b = u.pm >> 5, row0 = u.pm * 256 + wr * 64 + fr, cin = u.pn * 256 + wc * 32 + 8 * fq, cout = u.pn * 128 + wc * 32 + 8 * fq;
        f32x4 bs[2][2];
#pragma unroll
        for (int bj = 0; bj < 2; ++bj)
#pragma unroll
            for (int n = 0; n < 2; ++n) bs[bj][n] = *(const GAS f32x4*)(bias + (size_t)b * NFF2 + cin + bj * 128 + 4 * n);
#pragma unroll
        for (int ai = 0; ai < 2; ++ai)
#pragma unroll
            for (int m = 0; m < 4; ++m) {
                const int row = row0 + ai * 128 + m * 16; const float rstd = rs[ai * 128 + wr * 64 + m * 16 + fr];
                float hv[8];
#pragma unroll
                for (int n = 0; n < 2; ++n) { const f32x4 a = acc[ai][0][m][n] * rstd + bs[0][n], bb = acc[ai][1][m][n] * rstd + bs[1][n];
#pragma unroll
                    for (int e = 0; e < 4; ++e) hv[4 * n + e] = a[e] * sigmoidf_(a[e]) * bb[e]; }
                v4u w; w.x = pg8::cvt_pk_bf16(hv[0], hv[1]); w.y = pg8::cvt_pk_bf16(hv[2], hv[3]); w.z = pg8::cvt_pk_bf16(hv[4], hv[5]); w.w = pg8::cvt_pk_bf16(hv[6], hv[7]);
                *(GAS v4u*)(hid + (size_t)row * DFF + cout) = w;
            }
    }
};
struct EpiProj {
    static constexpr bool PERM = true; static constexpr bool BJ32 = true;
    const LAS float* rs; const float* bias; const float* lb; bf16* out;
    template <int TYP> __device__ __forceinline__ void body(const pg8::f32x4 (&acc)[2][2][4][2], const pg8::Unit& u, int wr, int wc, int fr, int fq) const {
        const int b = u.pm >> 5, row0 = u.pm * 256 + wr * 64 + fr, cin = u.pn * 256 + wc * 64 + 8 * fq, cout = (u.pn & 7) * 256 + wc * 64 + 8 * fq;
        bf16* dst = out + (size_t)TYP * M * D;
        const bool lo = fr < 8; const int srow = (fr & 7) - fr, scol = lo ? 0 : 32;
        f32x4 bs[2][2], lbv[2][2];
#pragma unroll
        for (int bj = 0; bj < 2; ++bj)
#pragma unroll
            for (int n = 0; n < 2; ++n) { bs[bj][n] = *(const GAS f32x4*)(bias + (size_t)b * NPROJ + cin + bj * 32 + 4 * n); lbv[bj][n] = (TYP == 1) ? *(const GAS f32x4*)(lb + cout + bj * 32 + 4 * n) : (f32x4){0.f, 0.f, 0.f, 0.f}; }
#pragma unroll
        for (int ai = 0; ai < 2; ++ai)
#pragma unroll
            for (int m = 0; m < 4; ++m) {
                const int row = row0 + ai * 128 + m * 16; const float rstd = rs[ai * 128 + wr * 64 + m * 16 + fr];
                v4u wq[2];
#pragma unroll
                for (int bj = 0; bj < 2; ++bj) {
                    float r[8];
#pragma unroll
                    for (int n = 0; n < 2; ++n) { const f32x4 v = acc[ai][bj][m][n] * rstd + bs[bj][n];
#pragma unroll
                        for (int e = 0; e < 4; ++e) { float x = v[e];
                            if (TYP == 1) { const float lo = lbv[bj][n][e]; x = __logf(lo + (1.0f - lo) * sigmoidf_(x)); }
                            if (TYP == 3) x = x * sigmoidf_(x);
                            r[4 * n + e] = x; } }
                    wq[bj].x = pg8::cvt_pk_bf16(r[0], r[1]); wq[bj].y = pg8::cvt_pk_bf16(r[2], r[3]); wq[bj].z = pg8::cvt_pk_bf16(r[4], r[5]); wq[bj].w = pg8::cvt_pk_bf16(r[6], r[7]);
                }
                { v4u s1, s2; swap8(lo, wq[0], wq[1], s1, s2); const size_t so = (size_t)(row + srow) * D + cout + scol; *(GAS v4u*)(dst + so) = s1; *(GAS v4u*)(dst + so + 8 * D) = s2; }
            }
    }
    __device__ __forceinline__ void operator()(const pg8::f32x4 (&acc)[2][2][4][2], const pg8::Unit& u, int wr, int wc, int fr, int fq) const {
        const int typ = u.pn >> 3;
        if (typ == 1) body<1>(acc, u, wr, wc, fr, fq); else if (typ == 3) body<3>(acc, u, wr, wc, fr, fq); else if (typ == 0) body<0>(acc, u, wr, wc, fr, fq); else body<2>(acc, u, wr, wc, fr, fq);
    }
};
struct EpiNull {
    static constexpr bool PERM = true; static constexpr bool BJ32 = false;
    float* dummy;
    __device__ __forceinline__ void operator()(const pg8::f32x4 (&acc)[2][2][4][2], const pg8::Unit& u, int wr, int wc, int fr, int fq) const {
        f32x4 s = {0.f, 0.f, 0.f, 0.f};
#pragma unroll
        for (int ai = 0; ai < 2; ++ai)
#pragma unroll
            for (int bj = 0; bj < 2; ++bj)
#pragma unroll
                for (int m = 0; m < 4; ++m)
#pragma unroll
                    for (int n = 0; n < 2; ++n) s += acc[ai][bj][m][n];
        if (s.x + s.y + s.z + s.w == 12345.678f) dummy[(u.pm * 64 + u.pn) * 512 + threadIdx.x] = s.x;
    }
};
#ifndef MK_RX
#define MK_RX 0
#endif
#ifndef MK_XP
#define MK_XP 0
#endif
#ifndef MK_REPEAT_NULL
#define MK_REPEAT_NULL 0
#endif
#ifndef MK_REPEAT
#define MK_REPEAT -1
#endif
#ifndef MK_REPEAT_N
#define MK_REPEAT_N 1
#endif
#ifndef MK_NAIVE_REC
#define MK_NAIVE_REC 0
#endif
#ifndef MK_SP2
#define MK_SP2 true
#endif
#ifndef MK_ALIGN
#define MK_ALIGN true
#endif

struct Args { const float* in[15]; float* out; unsigned char* ws; int ph_lo, ph_hi; };
struct RowSplitOrder : pg8::StaticOrder {
    __device__ bool next(int i, pg8::Unit& u) const {
        if (G != 256 || nM != 64 || nN != 8) return pg8::StaticOrder::next(i, u);
        if (i >= 2) return false;
        const int x = c & 7, off = c >> 3; u.pm = 8 * x + 4 * i + (off & 3); u.pn = off >> 2; return true;
    }
};
template <int l> __device__ __forceinline__ void layer_phases(Frame& F, const Args& args, const XcdBarrier& bar, int lo, int hi) {
#define IN(k) (lo <= (k) && (k) < hi)
#define SEAM(k) do { if (IN(k) && IN((k) + 1)) xcd_barrier(bar, F.wave); } while (0)
#define RUNPH(k, ...) do { if (IN(k)) { F.lane = lane_id(); F.tid = F.wave * 64 + F.lane; if (MK_REPEAT == (k)) { _Pragma("unroll") for (int _r = 0; _r < MK_REPEAT_N; ++_r) { { __VA_ARGS__ } xcd_barrier(bar, F.wave); } } { __VA_ARGS__ } } } while (0)
    unsigned short* X = (unsigned short*)(args.ws + WS_X); bf16* XG = (bf16*)(args.ws + WS_XG); bf16* AOP = (bf16*)(args.ws + WS_AOP); bf16* HID = (bf16*)(args.ws + WS_HID); bf16* PROJ = (bf16*)(args.ws + WS_PROJ);
    float* SS = (float*)(args.ws + WS_SS);
    unsigned short* DX = (unsigned short*)(args.ws + WS_END); bf16* DXG = (bf16*)(args.ws + WS_END + 128 * MiB); float* DSS = (float*)(args.ws + WS_END + 192 * MiB);
    int rep_i = 0; (void)rep_i; (void)DX; (void)DXG; (void)DSS;
    constexpr int pb = 3 + (l >> 1) * 10 + (l & 1) * 4, j = l >> 1;
    constexpr bool pool = (l & 1) == 0;
    constexpr int pf = pool ? pb + 2 : pb + 4;
    const void* xsrc = (l == 0) ? (const void*)F.x : (const void*)X;
    if constexpr (pool) {
        if constexpr (l != 0) { RUNPH(pb, phase_poolprep<false>(F, l, xsrc);); SEAM(pb); }
    } else {
        RUNPH(pb,
            pg8::Gemm g{XG, (const bf16*)(args.ws + WS_WHIN) + (size_t)j * NPROJ * D, D, D, D, 0}; pg8::StaticOrder S; S.init(M, NPROJ, F.G, (int)blockIdx.x);
            { pg8::Unit u0; if (S.next(0, u0)) phase_row_rstd(F, SS, u0.pm); }
            EpiProj E{(const LAS float*)(F.lds + RS_OFF), F.vec + V_BIASP + (size_t)j * 2 * NPROJ, F.vec + V_LB + j * D, PROJ};
            pg8::gemm_phase<EpiProj, pg8::StaticOrder, MK_ALIGN, MK_SP2>(F.lds + RING_OFF, g, S, E, F.wave);
        ); SEAM(pb);
        RUNPH(pb + 1, phase_rec<false>(F, j);); SEAM(pb + 1);
        RUNPH(pb + 2, if (MK_RX != 0 && MK_REPEAT == pb + 2 && rep_i++ < MK_REPEAT_N) phase_rec<true, MK_RX>(F, j); else phase_rec<true>(F, j);); SEAM(pb + 2);
    }
    RUNPH(pf - 1,
        const bool dmy = (MK_REPEAT == pf - 1) && (rep_i++ < MK_REPEAT_N);
        pg8::Gemm g{AOP, pool ? (const bf16*)(args.ws + WS_WPOOL) + (size_t)j * 4 * PGD * PGD : (const bf16*)(args.ws + WS_WHOUT) + (size_t)j * D * D, D, pool ? PGD : D, pool ? PGD : D, pool ? PGD * 2 : 0};
        RowSplitOrder S; S.init(M, D, F.G, (int)blockIdx.x);
        EpiResid<l == 0> E{xsrc, dmy ? DX : X, dmy ? DXG : XG, dmy ? DSS : SS, F.vec + V_GATEM + l * 2 * D, F.vec + V_GF + l * 2 * D};
        pg8::gemm_phase<EpiResid<l == 0>, RowSplitOrder, MK_ALIGN, MK_SP2>(F.lds + RING_OFF, g, S, E, F.wave);
    ); SEAM(pf - 1);
    RUNPH(pf,
        pg8::Gemm g{XG, (const bf16*)(args.ws + WS_WFIN) + (size_t)l * NFF2 * D, D, D, D, 0}; pg8::StaticOrder S; S.init(M, NFF2, F.G, (int)blockIdx.x);
        { pg8::Unit u0; if (S.next(0, u0)) phase_row_rstd(F, SS, u0.pm); }
        if (MK_REPEAT_NULL && MK_REPEAT == pf && rep_i++ < MK_REPEAT_N) { EpiNull E0{DSS}; pg8::gemm_phase<EpiNull, pg8::StaticOrder, MK_ALIGN, MK_SP2, MK_XP>(F.lds + RING_OFF, g, S, E0, F.wave); }
        else {
        EpiSwiglu E{(const LAS float*)(F.lds + RS_OFF), F.vec + V_BIASF + (size_t)l * 2 * NFF2, HID};
        pg8::gemm_phase<EpiSwiglu, pg8::StaticOrder, MK_ALIGN, MK_SP2>(F.lds + RING_OFF, g, S, E, F.wave); }
    ); SEAM(pf);
    RUNPH(pf + 1,
        const bool dmy = (MK_REPEAT == pf + 1) && (rep_i++ < MK_REPEAT_N);
        pg8::Gemm g{HID, (const bf16*)(args.ws + WS_WFOUT) + (size_t)l * D * DFF, DFF, DFF, DFF, 0}; RowSplitOrder S; S.init(M, D, F.G, (int)blockIdx.x);
        EpiResid<false, pool> E{X, dmy ? DX : X, dmy ? DXG : XG, dmy ? DSS : SS, F.vec + V_GATEF + l * 2 * D, F.vec + V_GM + ((l + 1) & 3) * 2 * D};
        pg8::gemm_phase<EpiResid<false, pool>, RowSplitOrder, MK_ALIGN, MK_SP2>(F.lds + RING_OFF, g, S, E, F.wave);
    ); SEAM(pf + 1);
#undef RUNPH
#undef IN
#undef SEAM
}
__global__ void __launch_bounds__(NWAVES * 64, 2) mk_fwd(Args args) {
    extern __shared__ __attribute__((aligned(16))) unsigned char lds[];
    Frame F;
    F.lds = (LAS unsigned char*)lds;
    F.tid = threadIdx.x; F.lane = F.tid & 63; F.wave = __builtin_amdgcn_readfirstlane(F.tid >> 6); F.G = gridDim.x;
    F.x = args.in[0]; F.c = args.in[1]; F.gmix = args.in[2]; F.gffn = args.in[3]; F.wada = args.in[4]; F.bada = args.in[5]; F.poolw = args.in[6]; F.pools = args.in[7];
    F.hwin = args.in[8]; F.hwout = args.in[9]; F.hgain = args.in[10]; F.hlb = args.in[11]; F.wfin = args.in[12]; F.wfout = args.in[13]; F.fgain = args.in[14];
    F.out = args.out; F.ws = args.ws; F.vec = (float*)(args.ws + WS_VEC);
    volatile LAS unsigned* MISC = (volatile LAS unsigned*)(F.lds + MISC_OFF);
    for (int u = F.tid; u < (LDS_BYTES - LDSCTL_OFF) / 4; u += NWAVES * 64) ((LAS unsigned*)(F.lds + LDSCTL_OFF))[u] = 0u;
    __syncthreads();
    const int lo = args.ph_lo, hi = args.ph_hi;
    const bool multi = (hi - lo) > 1;
    XcdBarrier bar; bar.bar = (unsigned*)(args.ws + WS_CTL) + CW_BAR; bar.x = 0; bar.st = nullptr;
    if (multi) bar = xcd_barrier_post((unsigned*)(args.ws + WS_CTL) + CW_BAR, MISC + 8);
#define IN(k) (lo <= (k) && (k) < hi)
#define SEAM(k) do { if (IN(k) && IN((k) + 1)) xcd_barrier(bar, F.wave); } while (0)

#define RUNPH(k, ...) do { if (IN(k)) { F.lane = lane_id(); F.tid = F.wave * 64 + F.lane; if (MK_REPEAT == (k)) { _Pragma("unroll") for (int _r = 0; _r < MK_REPEAT_N; ++_r) { { __VA_ARGS__ } xcd_barrier(bar, F.wave); } } { __VA_ARGS__ } } } while (0)
    RUNPH(0, phase_p0a(F);); SEAM(0);
    RUNPH(1, phase_p0b(F);); SEAM(1);
    RUNPH(2, phase_p0c(F); __syncthreads(); phase_poolprep<true>(F, 0, (const void*)F.x);); SEAM(2);

    layer_phases<0>(F, args, bar, lo, hi); layer_phases<1>(F, args, bar, lo, hi); layer_phases<2>(F, args, bar, lo, hi); layer_phases<3>(F, args, bar, lo, hi);
    RUNPH(NPHASE - 1, phase_final(F););
#undef RUNPH
#undef IN
#undef SEAM
}

#ifndef MK_N_LAUNCHES
#define MK_N_LAUNCHES 1
#endif
extern "C" void kernel_launch(void* const* d_in, const int* in_sizes, int n_in, void* d_out, int out_size, void* d_ws, size_t ws_size, hipStream_t stream) {
    static int grid = 0;
    if (grid == 0) {
        if (n_in != 15 || in_sizes[0] != M * D || out_size != M * D || ws_size < WS_END) { fprintf(stderr, "kernel_launch: unexpected shapes (n_in %d in0 %d out %d ws %zu)\n", n_in, n_in > 0 ? in_sizes[0] : -1, out_size, ws_size); grid = -1; return; }
        int dev = 0, cus = 0, per_cu = 0;
        if (hipGetDevice(&dev) != hipSuccess || hipDeviceGetAttribute(&cus, hipDeviceAttributeMultiprocessorCount, dev) != hipSuccess) { grid = -1; return; }
        if (hipFuncSetAttribute((const void*)mk_fwd, hipFuncAttributeMaxDynamicSharedMemorySize, LDS_BYTES) != hipSuccess) { fprintf(stderr, "kernel_launch: hipFuncSetAttribute failed\n"); grid = -1; return; }
        if (hipOccupancyMaxActiveBlocksPerMultiprocessor(&per_cu, (const void*)mk_fwd, NWAVES * 64, LDS_BYTES) != hipSuccess || per_cu < 1) fprintf(stderr, "kernel_launch: occupancy query says %d\n", per_cu);
        (void)hipGetLastError();
        grid = cus;
    }
    if (grid < 0) return;
    if (hipMemsetAsync((char*)d_ws + WS_CTL, 0, CTL_ZERO_BYTES, stream) != hipSuccess) return;
    Args a{};
    for (int i = 0; i < 15; ++i) a.in[i] = (const float*)d_in[i];
    a.out = (float*)d_out; a.ws = (unsigned char*)d_ws;
    if (MK_N_LAUNCHES == 1) { a.ph_lo = 0; a.ph_hi = NPHASE; hipLaunchKernelGGL(mk_fwd, dim3(grid), dim3(NWAVES * 64), LDS_BYTES, stream, a); }
    else for (int p = 0; p < NPHASE; ++p) { a.ph_lo = p; a.ph_hi = p + 1; hipLaunchKernelGGL(mk_fwd, dim3(grid), dim3(NWAVES * 64), LDS_BYTES, stream, a); }
}
```

```cpp
#include <hip/hip_runtime.h>
#include <cstdio>
#include <cstdint>
namespace pg8 {
#define PG8_LAS __attribute__((address_space(3)))
typedef unsigned short bf16_t;
typedef short bf16x8 __attribute__((ext_vector_type(8)));
typedef float f32x4 __attribute__((ext_vector_type(4)));
typedef unsigned u32x4 __attribute__((ext_vector_type(4)));
constexpr int BM = 256, BK = 64, HALF = 128, HTB = HALF * BK * 2  , STAGE_BYTES = 8 * HTB, NXCD = 8, WGM = 8;

__host__ __device__ __forceinline__ int lds_byte(int r, int c) { const int st = (r >> 4) * 2 + (c >> 5), rr = r & 15, cc = c & 31, ob = rr * 64 + cc * 2; return st * 1024 + (ob ^ (((ob >> 9) & 1) << 5)); }
__host__ __device__ __forceinline__ void stage_rc(int b, int& R, int& C) { const int st = b / 1024, sb = b % 1024, swz = sb ^ (((sb >> 9) & 1) << 5); R = (st >> 1) * 16 + swz / 64; C = (st & 1) * 32 + (swz % 64) / 2; }
__host__ __device__ __forceinline__ int perm32(int rho) { const int n = rho >> 4, i = rho & 15; return 8 * (i >> 2) + 4 * n + (i & 3); }

struct Unit { int pm, pn; };
struct Gemm { const bf16_t* A; const bf16_t* Bt; int lda, ldb, K, agrp_bytes; };

struct StaticOrder {
    int nM, nN, nwg, G, c;
    __host__ __device__ void init(int M, int N, int G_, int c_) { nM = M / BM; nN = N / BM; nwg = nM * nN; G = G_; c = c_; }
    __host__ __device__ bool next(int i, Unit& u) const {
        const long L = (long)i * G + c; if (L >= nwg) return false;
        int wgid = (int)L; { const int q = nwg / NXCD, r = nwg % NXCD, xcd = wgid % NXCD, off = wgid / NXCD; wgid = (xcd < r ? xcd * (q + 1) : r * (q + 1) + (xcd - r) * q) + off; }
        const int nig = WGM * nN, gid = wgid / nig, fm = gid * WGM, gsz = (nM - fm) < WGM ? (nM - fm) : WGM;
        u.pm = fm + ((wgid % nig) % gsz); u.pn = (wgid % nig) / gsz; return true;
    }
    __device__ __forceinline__ void a_ready(const Unit&) const {}
    __device__ __forceinline__ void done(const Unit&) const {}
};

__device__ __forceinline__ unsigned cvt_pk_bf16(float lo, float hi) { typedef float f2_ __attribute__((ext_vector_type(2))); typedef __bf16 b2_ __attribute__((ext_vector_type(2))); const f2_ v = {lo, hi}; return __builtin_bit_cast(unsigned, __builtin_convertvector(v, b2_)); }

template <class Epi, class Sched, bool ALIGN_EPI = false, bool SP2 = false, int XP = 0  >
__device__ __forceinline__ void gemm_phase(PG8_LAS unsigned char* lds, const Gemm g, const Sched& S, const Epi& E, const int wid) {
    const int lane = __builtin_amdgcn_mbcnt_hi(~0u, __builtin_amdgcn_mbcnt_lo(~0u, 0u)), tid = wid * 64 + lane, wr = wid >> 2, wc = wid & 3, fr = lane & 15, fq = lane >> 4;
    const int K = g.K, nt = K / BK;
    unsigned voffA[2], voffB[2];
#pragma unroll
    for (int i = 0; i < 2; ++i) { int R, C; stage_rc(tid * 16 + i * 8192, R, C); const int Rb = Epi::PERM ? ((Epi::BJ32 ? 64 * (R >> 5) : (R & ~31)) + perm32(R & 31)) : R;
        voffA[i] = (unsigned)(R * g.lda + C) * 2u; voffB[i] = (unsigned)(Rb * g.ldb + C) * 2u; }
    const unsigned kstep = (unsigned)(BK * 2);
    const unsigned hstepA = (unsigned)HALF * g.lda * 2, hstepB = (unsigned)(Epi::BJ32 ? 32 : HALF) * g.ldb * 2;
    const unsigned tstepA = 2 * hstepA, tstepB = 2u * HALF * g.ldb * 2;
    const __amdgpu_buffer_rsrc_t rsA = __builtin_amdgcn_make_buffer_rsrc((void*)g.A, (short)0, 0x7ffffff0, 0x00020000), rsB = __builtin_amdgcn_make_buffer_rsrc((void*)g.Bt, (short)0, 0x7ffffff0, 0x00020000);
    const unsigned ldsw = (unsigned)wid * 1024u;
    const int aoff = lds_byte(wr * 64 + fr, fq * 8), boff = lds_byte(wc * 32 + fr, fq * 8);
#define PG8_SA(b, h) (((b) * 2 + (h)) * HTB)
#define PG8_SB(b, h) ((4 + (b) * 2 + (h)) * HTB)
#define PG8_STAGE_A(bufoff, soff, voff) do { if (!(XP & 4)) _Pragma("unroll") for (int _i = 0; _i < 2; ++_i) \
        __builtin_amdgcn_raw_ptr_buffer_load_lds(rsA, (PG8_LAS void*)(lds + (bufoff) + ldsw + _i * 8192), 16, (int)(voff)[_i], (int)(soff), 0, 0); } while (0)
#define PG8_STAGE_B(bufoff, soff, voff) do { if (!(XP & 4)) _Pragma("unroll") for (int _i = 0; _i < 2; ++_i) \
        __builtin_amdgcn_raw_ptr_buffer_load_lds(rsB, (PG8_LAS void*)(lds + (bufoff) + ldsw + _i * 8192), 16, (int)(voff)[_i], (int)(soff), 0, 0); } while (0)
#define PG8_LDA(dst, b, h) do { if (!(XP & 2)) _Pragma("unroll") for (int m = 0; m < 4; ++m) _Pragma("unroll") for (int k = 0; k < 2; ++k) dst[m][k] = *(const PG8_LAS bf16x8*)(lds + PG8_SA(b, h) + aoff + m * 2048 + k * 1024); } while (0)
#define PG8_LDB(dst, b, h) do { if (!(XP & 2)) _Pragma("unroll") for (int n = 0; n < 2; ++n) _Pragma("unroll") for (int k = 0; k < 2; ++k) dst[n][k] = *(const PG8_LAS bf16x8*)(lds + PG8_SB(b, h) + boff + n * 2048 + k * 1024); } while (0)
#define PG8_MMA(ai, bj, At, Bt) do { if (!(XP & 8)) __builtin_amdgcn_s_setprio(1); _Pragma("unroll") for (int m = 0; m < 4; ++m) _Pragma("unroll") for (int n = 0; n < 2; ++n) _Pragma("unroll") for (int k = 0; k < 2; ++k) { \
        if (!(XP & 1)) acc[ai][bj][m][n] = __builtin_amdgcn_mfma_f32_16x16x32_bf16(Bt[n][k], At[m][k], acc[ai][bj][m][n], 0, 0, 0); else asm volatile("" :: "v"(Bt[n][k]), "v"(At[m][k])); } if (!(XP & 8)) __builtin_amdgcn_s_setprio(0); } while (0)
#define PG8_WAIT_V(n) do { if (!(XP & 16)) asm volatile("s_waitcnt vmcnt(" #n ")" ::: "memory"); } while (0)
#define PG8_WAIT_L(n) asm volatile("s_waitcnt lgkmcnt(" #n ")" ::: "memory")
#define PG8_BAR __builtin_amdgcn_s_barrier()
#define PG8_SCHED __builtin_amdgcn_sched_barrier(0)
    Unit cur, nxt; int ui = 0;
    if (!S.next(0, cur)) return;
    f32x4 acc[2][2][4][2];
#pragma unroll
    for (int a = 0; a < 2; ++a)
#pragma unroll
        for (int b = 0; b < 2; ++b)
#pragma unroll
            for (int m = 0; m < 4; ++m)
#pragma unroll
                for (int n = 0; n < 2; ++n) acc[a][b][m][n] = (f32x4){0.f, 0.f, 0.f, 0.f};
    bf16x8 At[4][2], B0[2][2], B1[2][2];
    if (XP & 2) { bf16x8 pat; _Pragma("unroll") for (int q = 0; q < 8; ++q) pat[q] = (short)(0x3c00 + ((tid * 37 + q * 11) & 0x3ff));
        _Pragma("unroll") for (int m = 0; m < 4; ++m) _Pragma("unroll") for (int k = 0; k < 2; ++k) At[m][k] = pat;
        _Pragma("unroll") for (int n = 0; n < 2; ++n) _Pragma("unroll") for (int k = 0; k < 2; ++k) { B0[n][k] = pat; B1[n][k] = pat; } }
    unsigned cA = (unsigned)cur.pm * tstepA + (unsigned)(cur.pn >> 1) * g.agrp_bytes, cB = (unsigned)cur.pn * tstepB;
    S.a_ready(cur);
    if constexpr (SP2) {
        PG8_STAGE_B(PG8_SB(0, 0), cB, voffB); PG8_STAGE_B(PG8_SB(0, 1), cB + hstepB, voffB); PG8_STAGE_A(PG8_SA(0, 0), cA, voffA); PG8_STAGE_A(PG8_SA(0, 1), cA + hstepA, voffA);
        E.after_stage(tid, cur);
        if (wr == 1) PG8_BAR;
        PG8_WAIT_V(2); PG8_BAR;
        PG8_STAGE_B(PG8_SB(1, 0), cB + kstep, voffB); PG8_STAGE_A(PG8_SA(1, 0), cA + kstep, voffA); PG8_STAGE_B(PG8_SB(1, 1), cB + hstepB + kstep, voffB);
        PG8_WAIT_V(6); PG8_BAR;
    } else {
        PG8_STAGE_B(PG8_SB(0, 0), cB, voffB); PG8_STAGE_A(PG8_SA(0, 0), cA, voffA); PG8_STAGE_B(PG8_SB(0, 1), cB + hstepB, voffB); PG8_STAGE_A(PG8_SA(0, 1), cA + hstepA, voffA);
        if (wr == 1) PG8_BAR;
        PG8_WAIT_V(4); PG8_BAR;
        PG8_STAGE_B(PG8_SB(1, 0), cB + kstep, voffB); PG8_STAGE_A(PG8_SA(1, 0), cA + kstep, voffA); PG8_STAGE_B(PG8_SB(1, 1), cB + hstepB + kstep, voffB);
        PG8_WAIT_V(6); PG8_BAR;
    }
    for (;;) {
        const bool has_next = S.next(ui + 1, nxt);
        const unsigned nA = has_next ? (unsigned)nxt.pm * tstepA + (unsigned)(nxt.pn >> 1) * g.agrp_bytes : cA, nB = has_next ? (unsigned)nxt.pn * tstepB : cB;
        for (int t = 0; t < nt; t += 2) {
            const bool last = (t == nt - 2);
            const unsigned a1 = cA + (unsigned)(t + 1) * kstep;
            const unsigned a2 = last ? nA : cA + (unsigned)(t + 2) * kstep, b2 = last ? nB : cB + (unsigned)(t + 2) * kstep;
            const unsigned a3 = a2 + kstep, b3 = b2 + kstep;
            if (last && has_next) S.a_ready(nxt);
            if constexpr (SP2) {
            PG8_LDB(B0, 0, 0); PG8_LDB(B1, 0, 1); PG8_SCHED; PG8_LDA(At, 0, 0); PG8_STAGE_A(PG8_SA(1, 1), a1 + hstepA, voffA);
            PG8_WAIT_V(8); PG8_WAIT_L(0); PG8_BAR; PG8_MMA(0, 0, At, B0); PG8_MMA(0, 1, At, B1); PG8_BAR; PG8_SCHED;
            PG8_LDA(At, 0, 1); PG8_STAGE_B(PG8_SB(0, 0), b2, voffB); PG8_STAGE_B(PG8_SB(0, 1), b2 + hstepB, voffB); PG8_STAGE_A(PG8_SA(0, 0), a2, voffA);
            PG8_WAIT_V(8); PG8_WAIT_L(0); PG8_BAR; PG8_MMA(1, 0, At, B0); PG8_MMA(1, 1, At, B1); PG8_BAR; PG8_SCHED;
            PG8_LDB(B0, 1, 0); PG8_LDB(B1, 1, 1); PG8_SCHED; PG8_LDA(At, 1, 0); PG8_STAGE_A(PG8_SA(0, 1), a2 + hstepA, voffA);
            PG8_WAIT_V(8); PG8_WAIT_L(0); PG8_BAR; PG8_MMA(0, 0, At, B0); PG8_MMA(0, 1, At, B1); PG8_BAR; PG8_SCHED;
            PG8_LDA(At, 1, 1); PG8_STAGE_B(PG8_SB(1, 0), b3, voffB); PG8_STAGE_B(PG8_SB(1, 1), b3 + hstepB, voffB); PG8_STAGE_A(PG8_SA(1, 0), a3, voffA);
            PG8_WAIT_V(8); PG8_WAIT_L(0); PG8_BAR; PG8_MMA(1, 0, At, B0); PG8_MMA(1, 1, At, B1); PG8_BAR; PG8_SCHED;
            } else {
            PG8_LDB(B0, 0, 0); PG8_SCHED; PG8_LDA(At, 0, 0); PG8_STAGE_A(PG8_SA(1, 1), a1 + hstepA, voffA);
            PG8_WAIT_L(8); PG8_BAR; PG8_WAIT_L(0); PG8_MMA(0, 0, At, B0); PG8_BAR; PG8_SCHED;
            PG8_LDB(B1, 0, 1); PG8_STAGE_B(PG8_SB(0, 0), b2, voffB);
            PG8_BAR; PG8_WAIT_L(0); PG8_MMA(0, 1, At, B1); PG8_BAR;
            PG8_LDA(At, 0, 1); PG8_STAGE_A(PG8_SA(0, 0), a2, voffA);
            PG8_BAR; PG8_WAIT_L(0); PG8_MMA(1, 0, At, B0); PG8_BAR; PG8_SCHED;
            PG8_STAGE_B(PG8_SB(0, 1), b2 + hstepB, voffB);
            PG8_WAIT_V(6); PG8_BAR; PG8_MMA(1, 1, At, B1); PG8_BAR;
            PG8_LDB(B0, 1, 0); PG8_SCHED; PG8_LDA(At, 1, 0); PG8_STAGE_A(PG8_SA(0, 1), a2 + hstepA, voffA);
            PG8_WAIT_L(8); PG8_BAR; PG8_WAIT_L(0); PG8_MMA(0, 0, At, B0); PG8_BAR; PG8_SCHED;
            PG8_LDB(B1, 1, 1); PG8_STAGE_B(PG8_SB(1, 0), b3, voffB);
            PG8_BAR; PG8_WAIT_L(0); PG8_MMA(0, 1, At, B1); PG8_BAR;
            PG8_LDA(At, 1, 1); PG8_STAGE_A(PG8_SA(1, 0), a3, voffA);
            PG8_BAR; PG8_WAIT_L(0); PG8_MMA(1, 0, At, B0); PG8_BAR; PG8_SCHED;
            PG8_STAGE_B(PG8_SB(1, 1), b3 + hstepB, voffB);
            PG8_WAIT_V(6); PG8_BAR; PG8_MMA(1, 1, At, B1); PG8_BAR;
            }
        }
        if constexpr (ALIGN_EPI) { if (wr == 0) PG8_BAR; }
        E(acc, cur, wr, wc, fr, fq); S.done(cur);
        if (!has_next) break;
#pragma unroll
        for (int a = 0; a < 2; ++a)
#pragma unroll
            for (int b = 0; b < 2; ++b)
#pragma unroll
                for (int m = 0; m < 4; ++m)
#pragma unroll
                    for (int n = 0; n < 2; ++n) acc[a][b][m][n] = (f32x4){0.f, 0.f, 0.f, 0.f};
        cur = nxt; cA = nA; cB = nB; ++ui;
        if constexpr (ALIGN_EPI) { if (wr == 1) PG8_BAR; }
    }
    PG8_WAIT_V(0);
    if constexpr (!ALIGN_EPI) { if (wr == 0) PG8_BAR; }
    PG8_BAR;
#undef PG8_SA
#undef PG8_SB
#undef PG8_STAGE_A
#undef PG8_STAGE_B
#undef PG8_LDA
#undef PG8_LDB
#undef PG8_MMA
#undef PG8_WAIT_V
#undef PG8_WAIT_L
#undef PG8_BAR
#undef PG8_SCHED
}
}
#ifndef MK_SEGLEN
#define MK_SEGLEN 1024
#endif
constexpr int NWAVES = 8;
constexpr int BATCH = 2, SEQ = 8192, D = 2048, M = BATCH * SEQ, DFF = 5632, NFF2 = 2 * DFF, NPROJ = 4 * D, NMOD = 6 * D, DEPTH = 4;
constexpr int HEADS = 16, HD = 128, PGD = 512;
constexpr float EPS = 1e-6f;
constexpr int KC = 32, KR = D / KC;
constexpr int NPHASE = 24;

constexpr size_t MiB = 1u << 20;
constexpr size_t WS_CTL = 0, CTL_ZERO_BYTES = 1 * MiB;
constexpr size_t WS_PART = 1 * MiB;
constexpr size_t WS_VEC = 14 * MiB;
constexpr size_t WS_SS = 16 * MiB;
constexpr size_t WS_REC = 18 * MiB;
constexpr size_t WS_WPOOL = 36 * MiB, WS_WHOUT = 40 * MiB, WS_WHIN = 56 * MiB, WS_WFIN = 120 * MiB, WS_WFOUT = 296 * MiB;
constexpr size_t WS_X = 384 * MiB, WS_XG = 512 * MiB, WS_AOP = 576 * MiB, WS_HID = 640 * MiB, WS_PROJ = 816 * MiB, WS_END = 1072 * MiB;
constexpr int V_SHM = 0, V_SHF = V_SHM + DEPTH * 2 * D, V_GM = V_SHF + DEPTH * 2 * D, V_GF = V_GM + DEPTH * 2 * D, V_GATEM = V_GF + DEPTH * 2 * D, V_GATEF = V_GATEM + DEPTH * 2 * D,
              V_LB = V_GATEF + DEPTH * 2 * D, V_BIASP = V_LB + 2 * D, V_BIASF = V_BIASP + 2 * 2 * NPROJ, V_END = V_BIASF + DEPTH * 2 * NFF2;
static_assert((size_t)V_END * 4 <= 2 * MiB, "vec region");
constexpr int CW_TMO = 0, CW_BAR = 4096;

constexpr int RING_OFF = 0, RING_BYTES = 131072;
constexpr int LDSCTL_OFF = RING_BYTES, MISC_OFF = LDSCTL_OFF + 320;
constexpr int LDS_BYTES = 147456;

#define GAS __attribute__((address_space(1)))
#define LAS __attribute__((address_space(3)))
typedef unsigned short bf16;
typedef unsigned v4u __attribute__((ext_vector_type(4)));
typedef unsigned v2u __attribute__((ext_vector_type(2)));
typedef float f32x4 __attribute__((ext_vector_type(4)));
typedef GAS unsigned gu32;
#define RLX_AGENT __ATOMIC_RELAXED, __HIP_MEMORY_SCOPE_AGENT
#define LDS_WAIT() asm volatile("s_waitcnt lgkmcnt(0)" ::: "memory")
#define VM_WAIT() asm volatile("s_waitcnt vmcnt(0)" ::: "memory")
__device__ __forceinline__ unsigned f2bf(float f) { unsigned u = __builtin_bit_cast(unsigned, f); return (u + 0x7fffu + ((u >> 16) & 1u)) >> 16; }
__device__ __forceinline__ unsigned pk2(float lo, float hi) { return f2bf(lo) | (f2bf(hi) << 16); }
__device__ __forceinline__ float bf2f(unsigned short b) { return __builtin_bit_cast(float, (unsigned)b << 16); }
__device__ __forceinline__ float bflo(unsigned w) { return __builtin_bit_cast(float, w << 16); }
__device__ __forceinline__ float bfhi(unsigned w) { return __builtin_bit_cast(float, w & 0xffff0000u); }
typedef _Float16 h2_t __attribute__((ext_vector_type(2)));
typedef float f32x2_t __attribute__((ext_vector_type(2)));
__device__ __forceinline__ unsigned pkh2(float lo, float hi) { const f32x2_t v = {lo, hi}; return __builtin_bit_cast(unsigned, __builtin_convertvector(v, h2_t)); }
__device__ __forceinline__ f32x2_t unph2(unsigned w) { return __builtin_convertvector(__builtin_bit_cast(h2_t, w), f32x2_t); }
__device__ __forceinline__ float sigmoidf_(float v) { return __builtin_amdgcn_rcpf(1.0f + __expf(-v)); }

#define XB_TMO      128
#define XB_XCNT(j)  (256  + 64 * (j))
#define XB_XSUB(j)  (1280 + 64 * (j))
#define XB_XGEN(j)  (2304 + 64 * (j))
#define XB_TOP      3328
#define XB_TOPGEN   3392
#define XCD_BAR_WORDS 3456
#define XB_SPIN_CAP (1u << 18)

__device__ __forceinline__ unsigned xb_ld(unsigned* p)              { return __hip_atomic_load(p, __ATOMIC_RELAXED, __HIP_MEMORY_SCOPE_AGENT); }
__device__ __forceinline__ unsigned xb_add(unsigned* p, unsigned v) { return __hip_atomic_fetch_add(p, v, __ATOMIC_RELAXED, __HIP_MEMORY_SCOPE_AGENT); }
__device__ __forceinline__ unsigned xb_xcc_id() { return (unsigned)__builtin_amdgcn_s_getreg((3 << 11) | 20) & 0xFu; }
#define XB_SPIN(cond, bar) do { unsigned _sp = 0; while (cond) { __builtin_amdgcn_s_sleep(1); \
    if ((++_sp & 255u) == 0u) { if (xb_ld(&(bar)[XB_TMO])) break; if (_sp > XB_SPIN_CAP) { atomicAdd(&(bar)[XB_TMO], 1u); break; } } } } while (0)

struct XcdBarrier { unsigned* bar; unsigned x; volatile LAS unsigned* st; };

__device__ __forceinline__ XcdBarrier xcd_barrier_post(unsigned* bar, volatile LAS unsigned* st) {
    XcdBarrier b; b.bar = bar; b.x = xb_xcc_id(); b.st = st;
    if (threadIdx.x == 0) (void)xb_add(&bar[XB_XCNT(b.x)], 1u);
    return b;
}
__device__ __forceinline__ void xcd_barrier_complete(unsigned* bar, unsigned x, unsigned& nloc, unsigned& nx) {
    const unsigned G = gridDim.x * gridDim.y * gridDim.z;
    unsigned sum, cnt, mine, sp = 0u;
    for (;;) {
        sum = 0u; cnt = 0u; mine = 0u;
#pragma unroll
        for (unsigned j = 0; j < 16; ++j) { const unsigned c = xb_ld(&bar[XB_XCNT(j)]); sum += c; cnt += (c > 0u) ? 1u : 0u; mine = (j == x) ? c : mine; }
        if (sum == G) break;
        __builtin_amdgcn_s_sleep(1);
        if ((++sp & 255u) == 0u) { if (xb_ld(&bar[XB_TMO])) break; if (sp > XB_SPIN_CAP) { atomicAdd(&bar[XB_TMO], 1u); break; } }
    }
    nloc = mine > 0u ? mine : 1u; nx = cnt > 0u ? cnt : 1u;
}
__device__ __forceinline__ void xcd_barrier(const XcdBarrier& b, const int wave) {
    asm volatile("s_waitcnt vmcnt(0)" ::: "memory");
    __syncthreads();
    if (wave == 0 && __builtin_amdgcn_mbcnt_hi(~0u, __builtin_amdgcn_mbcnt_lo(~0u, 0u)) == 0) {
        unsigned* bar = b.bar;
        __builtin_amdgcn_s_waitcnt(0);
        unsigned nloc = b.st[0], nx = b.st[1];
        if (nloc == 0u) { xcd_barrier_complete(bar, b.x, nloc, nx); b.st[0] = nloc; b.st[1] = nx; }
        const unsigned old = xb_add(&bar[XB_XSUB(b.x)], 1u);
        const unsigned gen = old / nloc;
        if (old + 1u == (gen + 1u) * nloc) {
            __builtin_amdgcn_fence(__ATOMIC_RELEASE, "agent");
            asm volatile("s_waitcnt vmcnt(0)" ::: "memory");
            const unsigned og = xb_add(&bar[XB_TOP], 1u);
            const unsigned tg = og / nx;
            if (og + 1u == (tg + 1u) * nx) xb_add(&bar[XB_TOPGEN], 1u);
            else XB_SPIN(xb_ld(&bar[XB_TOPGEN]) == tg, bar);
            __builtin_amdgcn_fence(__ATOMIC_ACQUIRE, "agent");
            xb_add(&bar[XB_XGEN(b.x)], 1u);
            asm volatile("s_waitcnt vmcnt(0)" ::: "memory");
        } else {
            XB_SPIN(xb_ld(&bar[XB_XGEN(b.x)]) == gen, bar);
            __builtin_amdgcn_fence(__ATOMIC_ACQUIRE, "agent");
            asm volatile("s_waitcnt vmcnt(0)" ::: "memory");
        }
    }
    __syncthreads();
}

struct Frame {
    LAS unsigned char* lds;
    int tid, lane, wave, G;
    const float *x, *c, *gmix, *gffn, *wada, *bada, *poolw, *pools, *hwin, *hwout, *hgain, *hlb, *wfin, *wfout, *fgain;
    float* out; unsigned char* ws;
    float* vec;
};
__device__ __forceinline__ int lane_id() { int l = __builtin_amdgcn_mbcnt_hi(~0u, __builtin_amdgcn_mbcnt_lo(~0u, 0u)); asm volatile("" : "+v"(l)); return l; }
__device__ __forceinline__ float wave_sum(float v) {
#pragma unroll
    for (int o = 1; o < 64; o <<= 1) v += __shfl_xor(v, o);
    return v;
}

struct CvtTile { f32x4 w[8]; };
__device__ __forceinline__ void cvt_load(CvtTile& t, const float* W, int N, int k0, int n0_src, int lane) {
#pragma unroll
    for (int i = 0; i < 8; ++i) t.w[i] = *(const GAS f32x4*)(W + (size_t)(k0 + 8 * i + (lane >> 3)) * N + n0_src + 4 * (lane & 7));
}
template <bool BIAS>
__device__ __forceinline__ void cvt_store(const CvtTile& t, bf16* WT, int K, int k0, int n0_dst, LAS float* scr, int lane, const LAS float* shL, int Ktot, float (&bacc)[2][4]) {
#pragma unroll
    for (int i = 0; i < 8; ++i) { LAS float* p = scr + (8 * i + (lane >> 3)) * 33 + 4 * (lane & 7); p[0] = t.w[i].x; p[1] = t.w[i].y; p[2] = t.w[i].z; p[3] = t.w[i].w; }
    LDS_WAIT(); asm volatile("" ::: "memory");
    const int c = lane & 7;
    f32x4 s0a, s0b, s1a, s1b;
    if (BIAS) { s0a = *(const LAS f32x4*)(shL + k0 + 8 * c); s0b = *(const LAS f32x4*)(shL + k0 + 8 * c + 4); s1a = *(const LAS f32x4*)(shL + Ktot + k0 + 8 * c); s1b = *(const LAS f32x4*)(shL + Ktot + k0 + 8 * c + 4); }
#pragma unroll
    for (int j = 0; j < 4; ++j) { const int n = (lane >> 3) + 8 * j; const LAS float* s = scr + (8 * c) * 33 + n;
        const float v0 = s[0 * 33], v1 = s[1 * 33], v2 = s[2 * 33], v3 = s[3 * 33], v4 = s[4 * 33], v5 = s[5 * 33], v6 = s[6 * 33], v7 = s[7 * 33];
        if (BIAS) { bacc[0][j] += (v0 * s0a.x + v1 * s0a.y) + (v2 * s0a.z + v3 * s0a.w) + (v4 * s0b.x + v5 * s0b.y) + (v6 * s0b.z + v7 * s0b.w);
                    bacc[1][j] += (v0 * s1a.x + v1 * s1a.y) + (v2 * s1a.z + v3 * s1a.w) + (v4 * s1b.x + v5 * s1b.y) + (v6 * s1b.z + v7 * s1b.w); }
        v4u o; o.x = pg8::cvt_pk_bf16(v0, v1); o.y = pg8::cvt_pk_bf16(v2, v3); o.z = pg8::cvt_pk_bf16(v4, v5); o.w = pg8::cvt_pk_bf16(v6, v7);
        *(GAS v4u*)(WT + (size_t)(n0_dst + n) * K + k0 + 8 * c) = o; }
    LDS_WAIT(); asm volatile("" ::: "memory");
}
__device__ __forceinline__ void convert_matrix(Frame& F, const float* W, int K, int N, bf16* WT, LAS float* scr, int& itbase) {
    const int gw = blockIdx.x * NWAVES + F.wave, NGW = F.G * NWAVES;
    const int nblk = N / 32, nitems = (K / 64) * nblk;
    int it = (gw - itbase % NGW + NGW) % NGW;
    float dummy[2][4];
    CvtTile cur, nxt;
    if (it < nitems) cvt_load(nxt, W, N, 64 * (it / nblk), 32 * (it % nblk), F.lane);
    for (; it < nitems; it += NGW) {
        cur = nxt; const int itn = it + NGW;
        if (itn < nitems) cvt_load(nxt, W, N, 64 * (itn / nblk), 32 * (itn % nblk), F.lane);
        cvt_store<false>(cur, WT, K, 64 * (it / nblk), 32 * (it % nblk), scr, F.lane, nullptr, 0, dummy);
    }
    itbase += nitems;
}

__device__ __forceinline__ void phase_p0a(Frame& F) {
    const int gw = blockIdx.x * NWAVES + F.wave, NGW = F.G * NWAVES, gt = blockIdx.x * (NWAVES * 64) + F.tid;
    LAS float* condL = (LAS float*)(F.lds + RING_OFF);
    for (int i = F.tid; i < 2 * D; i += NWAVES * 64) { const float cv = F.c[i]; condL[i] = cv * sigmoidf_(cv); }
    __syncthreads();
    float* part = (float*)(F.ws + WS_PART);
    for (int it = gw; it < DEPTH * KC * (NMOD / 256); it += NGW) {
        const int ns = it % (NMOD / 256), kc = (it / (NMOD / 256)) % KC, l = it / ((NMOD / 256) * KC);
        const float* W = F.wada + ((size_t)l * D + (size_t)kc * KR) * NMOD + ns * 256 + F.lane * 4;
        f32x4 a0 = {0.f, 0.f, 0.f, 0.f}, a1 = {0.f, 0.f, 0.f, 0.f};
        for (int k = 0; k < KR; k += 8) {
            f32x4 w[8];
#pragma unroll
            for (int j = 0; j < 8; ++j) w[j] = *(const GAS f32x4*)(W + (size_t)(k + j) * NMOD);
#pragma unroll
            for (int j = 0; j < 8; ++j) { const float c0 = condL[kc * KR + k + j], c1 = condL[D + kc * KR + k + j]; a0 += c0 * w[j]; a1 += c1 * w[j]; }
        }
        *(GAS f32x4*)(part + ((size_t)(kc * DEPTH + l) * 2 + 0) * NMOD + ns * 256 + F.lane * 4) = a0;
        *(GAS f32x4*)(part + ((size_t)(kc * DEPTH + l) * 2 + 1) * NMOD + ns * 256 + F.lane * 4) = a1;
    }
    if (gt < D) {
        const float l0 = F.hlb[gt], l1 = F.hlb[D + gt], l2 = F.hlb[2 * D + gt], l3 = F.hlb[3 * D + gt];
        const float mx = fmaxf(fmaxf(l0, l1), fmaxf(l2, l3));
        const float e0 = __expf(l0 - mx), e1 = __expf(l1 - mx), e2 = __expf(l2 - mx), e3 = __expf(l3 - mx), inv = 1.0f / (e0 + e1 + e2 + e3);
        F.vec[V_LB + gt] = e1 * inv; F.vec[V_LB + D + gt] = (e1 + e2 + e3) * inv;
    }
    float* ss = (float*)(F.ws + WS_SS);
    for (int m = gw; m < M; m += NGW) {
        const GAS f32x4* xr = (const GAS f32x4*)(F.x + (size_t)m * D) + F.lane; float s = 0.f;
#pragma unroll
        for (int j = 0; j < 8; ++j) { const f32x4 v = xr[64 * j]; s += (v.x * v.x + v.y * v.y) + (v.z * v.z + v.w * v.w); }
        s = wave_sum(s);
        if (F.lane == 0) ss[m] = s;
    }
    for (int i = gt; i < 31 * (M / 4); i += F.G * NWAVES * 64) ((GAS f32x4*)(ss + M))[i] = (f32x4){0.f, 0.f, 0.f, 0.f};
    __syncthreads();
    LAS float* scr = (LAS float*)(F.lds + RING_OFF + F.wave * 16384);
    int itbase = 0;
    for (int j = 0; j < 8; ++j) convert_matrix(F, F.poolw + (size_t)j * PGD * PGD, PGD, PGD, (bf16*)(F.ws + WS_WPOOL) + (size_t)j * PGD * PGD, scr, itbase);
    for (int j = 0; j < 2; ++j) convert_matrix(F, F.hwout + (size_t)j * D * D, D, D, (bf16*)(F.ws + WS_WHOUT) + (size_t)j * D * D, scr, itbase);
    for (int j = 0; j < DEPTH; ++j) convert_matrix(F, F.wfout + (size_t)j * DFF * D, DFF, D, (bf16*)(F.ws + WS_WFOUT) + (size_t)j * DFF * D, scr, itbase);
}
__device__ __forceinline__ void phase_p0b(Frame& F) {
    const int gt = blockIdx.x * (NWAVES * 64) + F.tid;
    if (gt >= DEPTH * 2 * (D / 4) * 6) return;
    const int cq = gt % (D / 4), r = gt / (D / 4), j = r % 6, b = (r / 6) % 2, l = r / 12, col = cq * 4;
    const float* part = (const float*)(F.ws + WS_PART);
    f32x4 s = *(const GAS f32x4*)(F.bada + (size_t)l * NMOD + j * D + col);
    f32x4 pv[KC];
#pragma unroll
    for (int kc = 0; kc < KC; ++kc) pv[kc] = *(const GAS f32x4*)(part + ((size_t)(kc * DEPTH + l) * 2 + b) * NMOD + j * D + col);
#pragma unroll
    for (int kc = 0; kc < KC; ++kc) s += pv[kc];
    const int vo = (l * 2 + b) * D + col;
    if (j == 0) *(GAS f32x4*)(F.vec + V_SHM + vo) = s;
    else if (j == 1) *(GAS f32x4*)(F.vec + V_GM + vo) = *(const GAS f32x4*)(F.gmix + (size_t)l * D + col) * (1.0f + s);
    else if (j == 2) { if ((l & 1) == 0) s = s * *(const GAS f32x4*)(F.pools + (size_t)(l >> 1) * D + col); *(GAS f32x4*)(F.vec + V_GATEM + vo) = s; }
    else if (j == 3) *(GAS f32x4*)(F.vec + V_SHF + vo) = s;
    else if (j == 4) *(GAS f32x4*)(F.vec + V_GF + vo) = *(const GAS f32x4*)(F.gffn + (size_t)l * D + col) * (1.0f + s);
    else *(GAS f32x4*)(F.vec + V_GATEF + vo) = s;
}
__device__ __forceinline__ void phase_p0c(Frame& F) {
    constexpr int NB_H = NPROJ / 256, NB_F = NFF2 / 256;
    constexpr int NITEMS = 2 * NB_H + DEPTH * NB_F;
    LAS float* shL = (LAS float*)(F.lds + RING_OFF);
    LAS float* scr = (LAS float*)(F.lds + RING_OFF + 16384 + F.wave * 12288);
    for (int bi = blockIdx.x; bi < NITEMS; bi += F.G) {
        const bool is_h = bi < 2 * NB_H;
        const int mi = is_h ? bi / NB_H : (bi - 2 * NB_H) / NB_F, grp = is_h ? bi % NB_H : (bi - 2 * NB_H) % NB_F;
        const int layer = is_h ? 2 * mi + 1 : mi;
        const int N = is_h ? NPROJ : NFF2;
        const float* W = is_h ? F.hwin + (size_t)mi * D * NPROJ : F.wfin + (size_t)mi * D * NFF2;
        bf16* WT = is_h ? (bf16*)(F.ws + WS_WHIN) + (size_t)mi * NPROJ * D : (bf16*)(F.ws + WS_WFIN) + (size_t)mi * NFF2 * D;
        const float* shv = F.vec + (is_h ? V_SHM : V_SHF) + (size_t)layer * 2 * D;
        float* biasv = F.vec + (is_h ? V_BIASP + (size_t)mi * 2 * NPROJ : V_BIASF + (size_t)mi * 2 * NFF2);
        __syncthreads();
        for (int i = F.tid; i < 2 * D; i += NWAVES * 64) shL[i] = shv[i];
        __syncthreads();
        const int n0_dst = grp * 256 + F.wave * 32;
        int n0_src = n0_dst;
        if (!is_h) { const int pn = n0_dst / 256, within = n0_dst % 256, bj = within / 128, j = within % 128; n0_src = bj * DFF + pn * 128 + j; }
        float bacc[2][4];
#pragma unroll
        for (int q = 0; q < 2; ++q)
#pragma unroll
            for (int jj = 0; jj < 4; ++jj) bacc[q][jj] = 0.f;
        CvtTile cur, nxt, nx2;
        cvt_load(nxt, W, N, 0, n0_src, F.lane); cvt_load(nx2, W, N, 64, n0_src, F.lane);
        for (int kb = 0; kb < D / 64; ++kb) {
            cur = nxt; nxt = nx2;
            if (kb + 2 < D / 64) cvt_load(nx2, W, N, 64 * (kb + 2), n0_src, F.lane);
            cvt_store<true>(cur, WT, D, 64 * kb, n0_dst, scr, F.lane, shL, D, bacc);
        }
#pragma unroll
        for (int q = 0; q < 2; ++q)
#pragma unroll
            for (int jj = 0; jj < 4; ++jj) { float v = bacc[q][jj]; v += __shfl_xor(v, 1); v += __shfl_xor(v, 2); v += __shfl_xor(v, 4);
                if ((F.lane & 7) == 0) biasv[q * N + n0_dst + (F.lane >> 3) + 8 * jj] = v; }
    }
}
template <bool XF32>
__device__ __forceinline__ void load_x8(const void* xsrc, size_t eoff, float (&v)[8]) {
    if (XF32) { const f32x4 a = *(const GAS f32x4*)((const float*)xsrc + eoff), b = *(const GAS f32x4*)((const float*)xsrc + eoff + 4);
        v[0] = a.x; v[1] = a.y; v[2] = a.z; v[3] = a.w; v[4] = b.x; v[5] = b.y; v[6] = b.z; v[7] = b.w; }
    else { const v4u a = *(const GAS v4u*)((const unsigned short*)xsrc + eoff); const f32x2_t p0 = unph2(a.x), p1 = unph2(a.y), p2 = unph2(a.z), p3 = unph2(a.w);
        v[0] = p0.x; v[1] = p0.y; v[2] = p1.x; v[3] = p1.y; v[4] = p2.x; v[5] = p2.y; v[6] = p3.x; v[7] = p3.y; }
}
template <bool XF32>
__device__ __forceinline__ void phase_poolprep(Frame& F, int layer, const void* xsrc) {
    LAS float* rs = (LAS float*)(F.lds + RING_OFF);
    const float* ss = (const float*)(F.ws + WS_SS);
    bf16* dst = (bf16*)(F.ws + WS_AOP);
    for (int ts = blockIdx.x; ts < M / 64; ts += F.G) {
        const int r0 = ts * 64, b = r0 / SEQ, t0 = r0 % SEQ;
        __syncthreads();
        if (F.tid < 80) { const int row = r0 - 16 + F.tid; float v = 0.f;
            if (t0 - 16 + F.tid >= 0) { float s = 0.f; for (int j = 0; j < 32; ++j) s += ss[(size_t)j * M + row]; v = rsqrtf(s * (1.0f / D) + EPS); }
            rs[F.tid] = v; }
        __syncthreads();
        const int half = F.tid >> 8, col = (F.tid & 255) * 8, g = col >> 9, w = 2 << g, rb = r0 + half * 32, tb = t0 + half * 32, ib = 16 + half * 32;
        float gm[8], sh[8], S[8], xv[8];
        { const f32x4 a = *(const GAS f32x4*)(F.vec + V_GM + (layer * 2 + b) * D + col), c = *(const GAS f32x4*)(F.vec + V_GM + (layer * 2 + b) * D + col + 4);
          gm[0] = a.x; gm[1] = a.y; gm[2] = a.z; gm[3] = a.w; gm[4] = c.x; gm[5] = c.y; gm[6] = c.z; gm[7] = c.w; }
        { const f32x4 a = *(const GAS f32x4*)(F.vec + V_SHM + (layer * 2 + b) * D + col), c = *(const GAS f32x4*)(F.vec + V_SHM + (layer * 2 + b) * D + col + 4);
          sh[0] = a.x; sh[1] = a.y; sh[2] = a.z; sh[3] = a.w; sh[4] = c.x; sh[5] = c.y; sh[6] = c.z; sh[7] = c.w; }
#pragma unroll
        for (int e = 0; e < 8; ++e) S[e] = 0.f;
        for (int j = 1; j < w; ++j) { if (tb - j >= 0) { load_x8<XF32>(xsrc, (size_t)(rb - j) * D + col, xv); const float r = rs[ib - j];
#pragma unroll
            for (int e = 0; e < 8; ++e) S[e] += xv[e] * r * gm[e] + sh[e]; } }
#pragma unroll 4
        for (int i = 0; i < 32; ++i) {
            const int t = tb + i;
            load_x8<XF32>(xsrc, (size_t)(rb + i) * D + col, xv);
            const float r = rs[ib + i]; const float inv = __builtin_amdgcn_rcpf((float)((t + 1 < w) ? (t + 1) : w));
            float dv[8];
#pragma unroll
            for (int e = 0; e < 8; ++e) { const float h = xv[e] * r * gm[e] + sh[e]; S[e] += h; dv[e] = S[e] * inv - h; }
            v4u o; o.x = pg8::cvt_pk_bf16(dv[0], dv[1]); o.y = pg8::cvt_pk_bf16(dv[2], dv[3]); o.z = pg8::cvt_pk_bf16(dv[4], dv[5]); o.w = pg8::cvt_pk_bf16(dv[6], dv[7]);
            *(GAS v4u*)(dst + (size_t)(rb + i) * D + col) = o;
            if (t - w + 1 >= 0) { load_x8<XF32>(xsrc, (size_t)(rb + i - w + 1) * D + col, xv); const float ro = rs[ib + i - w + 1];
#pragma unroll
                for (int e = 0; e < 8; ++e) S[e] -= xv[e] * ro * gm[e] + sh[e]; }
        }
    }
}
typedef short bf16x8_t __attribute__((ext_vector_type(8)));
__device__ __forceinline__ bf16x8_t frag2(const LAS unsigned char* p0, const LAS unsigned char* p1) {
    const v2u a = *(const LAS v2u*)p0, b = *(const LAS v2u*)p1; v4u r; r.x = a.x; r.y = a.y; r.z = b.x; r.w = b.y; return __builtin_bit_cast(bf16x8_t, r);
}
typedef short s16x4_t __attribute__((ext_vector_type(4)));
__device__ __forceinline__ bf16x8_t fragtr(const LAS unsigned char* p0, const LAS unsigned char* p1) {
    const s16x4_t a = __builtin_amdgcn_ds_read_tr16_b64_v4i16((LAS s16x4_t*)p0), b = __builtin_amdgcn_ds_read_tr16_b64_v4i16((LAS s16x4_t*)p1);
    const v2u ua = __builtin_bit_cast(v2u, a), ub = __builtin_bit_cast(v2u, b); v4u r; r.x = ua.x; r.y = ua.y; r.z = ub.x; r.w = ub.y; return __builtin_bit_cast(bf16x8_t, r);
}
__device__ __forceinline__ bf16x8_t packf(const f32x4 lo, const f32x4 hi) {
    v4u r; r.x = pg8::cvt_pk_bf16(lo.x, lo.y); r.y = pg8::cvt_pk_bf16(lo.z, lo.w); r.z = pg8::cvt_pk_bf16(hi.x, hi.y); r.w = pg8::cvt_pk_bf16(hi.z, hi.w); return __builtin_bit_cast(bf16x8_t, r);
}
template <int CTRL, int ROWMASK> __device__ __forceinline__ float dpp_f(float v) { return __builtin_bit_cast(float, __builtin_amdgcn_update_dpp(0, __builtin_bit_cast(int, v), CTRL, ROWMASK, 0xF, false)); }
namespace recl { constexpr int C = 32, QS = 272, TS = 288, OSS = 528;
    constexpr int DEC = 0, QH = 512, KT = QH + 32 * QS, KH = KT + 32 * QS, V = KH + 32 * TS, OS = V + 32 * TS, SET = OS + 32 * OSS; }
template <bool P2>
__device__ __forceinline__ void rec_prep(LAS unsigned char* lds, const v4u cq, const v4u clf, const v4u cv, const int lane, const int pt, const int pd8, float (&btot)[8]) {
    using namespace recl;
    float lf[8], x[8], bend[8];
    lf[0] = bflo(clf.x); lf[1] = bfhi(clf.x); lf[2] = bflo(clf.y); lf[3] = bfhi(clf.y); lf[4] = bflo(clf.z); lf[5] = bfhi(clf.z); lf[6] = bflo(clf.w); lf[7] = bfhi(clf.w);
#pragma unroll
    for (int e = 0; e < 8; ++e) { float xx = lf[e];
        xx += dpp_f<0x111, 0xF>(xx); xx += dpp_f<0x112, 0xF>(xx); xx += dpp_f<0x114, 0xF>(xx); xx += dpp_f<0x118, 0xF>(xx); xx += dpp_f<0x142, 0xA>(xx);
        x[e] = xx; const float e0v = __builtin_bit_cast(float, __builtin_amdgcn_readlane(__builtin_bit_cast(int, xx), 31)), e1v = __builtin_bit_cast(float, __builtin_amdgcn_readlane(__builtin_bit_cast(int, xx), 63));
        bend[e] = (lane < 32) ? e0v : e1v; }
    float qh[8], kt[8], kh[8];
    { float qq[8];
      qq[0] = bflo(cq.x); qq[1] = bfhi(cq.x); qq[2] = bflo(cq.y); qq[3] = bfhi(cq.y); qq[4] = bflo(cq.z); qq[5] = bfhi(cq.z); qq[6] = bflo(cq.w); qq[7] = bfhi(cq.w);
#pragma unroll
      for (int e = 0; e < 8; ++e) { const float bb = x[e], k = 1.0f - __expf(lf[e]);
          kh[e] = k * __expf(bend[e] - bb);
          if (P2) { qh[e] = qq[e] * __expf(bb); kt[e] = k * __expf(-bb); } else { qh[e] = 0.f; kt[e] = 0.f; btot[e] += bend[e]; } } }
    if (P2) {
        v4u wq, wk; wq.x = pg8::cvt_pk_bf16(qh[0], qh[1]); wq.y = pg8::cvt_pk_bf16(qh[2], qh[3]); wq.z = pg8::cvt_pk_bf16(qh[4], qh[5]); wq.w = pg8::cvt_pk_bf16(qh[6], qh[7]);
        wk.x = pg8::cvt_pk_bf16(kt[0], kt[1]); wk.y = pg8::cvt_pk_bf16(kt[2], kt[3]); wk.z = pg8::cvt_pk_bf16(kt[4], kt[5]); wk.w = pg8::cvt_pk_bf16(kt[6], kt[7]);
        *(LAS v4u*)(lds + QH + pt * QS + pd8 * 2) = wq; *(LAS v4u*)(lds + KT + pt * QS + pd8 * 2) = wk;
    }
    { v4u wh; wh.x = pg8::cvt_pk_bf16(kh[0], kh[1]); wh.y = pg8::cvt_pk_bf16(kh[2], kh[3]); wh.z = pg8::cvt_pk_bf16(kh[4], kh[5]); wh.w = pg8::cvt_pk_bf16(kh[6], kh[7]);
      *(LAS v4u*)(lds + KH + pt * TS + pd8 * 2) = wh; *(LAS v4u*)(lds + V + pt * TS + pd8 * 2) = cv; }
    if (pt == 31) { *(LAS f32x4*)(lds + DEC + pd8 * 4) = (f32x4){__expf(bend[0]), __expf(bend[1]), __expf(bend[2]), __expf(bend[3])};
                    *(LAS f32x4*)(lds + DEC + (pd8 + 4) * 4) = (f32x4){__expf(bend[4]), __expf(bend[5]), __expf(bend[6]), __expf(bend[7])}; }
}
template <bool P2, int RX = 0>
__device__ __forceinline__ void phase_rec(Frame& F, int j) {
    using namespace recl;
    constexpr int SEGLEN = MK_SEGLEN, NCH = SEGLEN / C, NSEG = SEQ / SEGLEN;
    static_assert(2 * SET <= RING_BYTES, "rec LDS");
    const int item = blockIdx.x; if (item >= BATCH * HEADS * NSEG) return;
    const int seq = item / NSEG, p = item % NSEG, b = seq >> 4, h = seq & 15;
    if (!P2 && p == NSEG - 1) return;
    LAS unsigned char* lds0 = F.lds + RING_OFF;
    const int tid = F.tid, lane = F.lane, w = F.wave, fr = lane & 15, g = lane >> 4;
    const int t = tid >> 4, d8 = (tid & 15) * 8;
    const int pt = lane & 31, pd8 = 16 * w + 8 * (lane >> 5);
    const bf16* Q = (const bf16*)(F.ws + WS_PROJ); const bf16* LF = Q + (size_t)M * D; const bf16* V_ = LF + (size_t)M * D; const bf16* Gt = V_ + (size_t)M * D;
    bf16* O = (bf16*)(F.ws + WS_AOP);
    float* Lst = (float*)(F.ws + WS_REC); float* DT = (float*)(F.ws + WS_REC + 16 * MiB);
    const size_t rowb = (size_t)b * SEQ + (size_t)p * SEGLEN;
    const size_t e0 = (rowb + t) * D + h * HD + d8, pe0 = (rowb + pt) * D + h * HD + pd8;
    f32x4 S[8];
#pragma unroll
    for (int i = 0; i < 8; ++i) S[i] = (f32x4){0.f, 0.f, 0.f, 0.f};
    float btot[8];
#pragma unroll
    for (int e = 0; e < 8; ++e) btot[e] = 0.f;
    if (P2) {
        for (int pp = 0; pp < p; ++pp) {
            const int it2 = seq * NSEG + pp;
#pragma unroll
            for (int dt = 0; dt < 8; ++dt) {
                const f32x4 dc = *(const GAS f32x4*)(DT + (size_t)it2 * HD + 16 * dt + 4 * g);
                const f32x4 lv = *(const GAS f32x4*)(Lst + ((((size_t)it2 * 8 + w) * 8 + dt) * 64 + lane) * 4);
                S[dt] = S[dt] * dc + lv;
            }
        }
    }
    f32x4 ga = {0.f, 0.f, 0.f, 0.f}, gb = ga;
    if (P2) { ga = *(const GAS f32x4*)(F.hgain + (size_t)j * D + h * HD + d8); gb = *(const GAS f32x4*)(F.hgain + (size_t)j * D + h * HD + d8 + 4); }
    const v4u z4u = {0u, 0u, 0u, 0u};
    { const v4u q0 = P2 ? *(const GAS v4u*)(Q + pe0) : z4u, l0 = *(const GAS v4u*)(LF + pe0), v0 = *(const GAS v4u*)(V_ + pe0);
      rec_prep<P2>(lds0, q0, l0, v0, lane, pt, pd8, btot); }
    v4u nq = z4u, nlf = z4u, nv = z4u;
    if (NCH > 1) { const size_t adv = (size_t)C * D; nlf = *(const GAS v4u*)(LF + pe0 + adv); nv = *(const GAS v4u*)(V_ + pe0 + adv); if (P2) nq = *(const GAS v4u*)(Q + pe0 + adv); }
    __syncthreads();
    for (int c = 0; c < NCH; ++c) {
        LAS unsigned char* lds = lds0 + (c & 1) * SET;
        LAS unsigned char* ldn = lds0 + ((c + 1) & 1) * SET;
        v4u cg = z4u; if (P2) cg = *(const GAS v4u*)(Gt + e0 + (size_t)c * C * D);
        const v4u cq = nq, clf = nlf, cv = nv;
        if (c + 2 < NCH) { const size_t adv = (size_t)(c + 2) * C * D;
            nlf = *(const GAS v4u*)(LF + pe0 + adv); nv = *(const GAS v4u*)(V_ + pe0 + adv); if (P2) nq = *(const GAS v4u*)(Q + pe0 + adv); }
        if (c + 1 < NCH) rec_prep<P2>(ldn, cq, clf, cv, lane, pt, pd8, btot);
        if (!(RX & 1)) {
        const int trq = fr >> 2, trp = fr & 3;
        const bf16x8_t vf = fragtr(lds + V + (4 * g + trq) * TS + (16 * w + 4 * trp) * 2, lds + V + (16 + 4 * g + trq) * TS + (16 * w + 4 * trp) * 2);
        if (P2) {
            bf16x8_t qf[2][4];
#pragma unroll
            for (int tt = 0; tt < 2; ++tt)
#pragma unroll
                for (int ks = 0; ks < 4; ++ks) qf[tt][ks] = frag2(lds + QH + (16 * tt + fr) * QS + (32 * ks + 4 * g) * 2, lds + QH + (16 * tt + fr) * QS + (32 * ks + 16 + 4 * g) * 2);
            f32x4 at0 = {0.f, 0.f, 0.f, 0.f}, at1 = at0, at2 = at0, o0 = at0, o1 = at0;
#pragma unroll
            for (int ks = 0; ks < 4; ++ks) { const bf16x8_t sf = packf(S[2 * ks], S[2 * ks + 1]);
                o0 = __builtin_amdgcn_mfma_f32_16x16x32_bf16(qf[0][ks], sf, o0, 0, 0, 0);
                o1 = __builtin_amdgcn_mfma_f32_16x16x32_bf16(qf[1][ks], sf, o1, 0, 0, 0); }
#pragma unroll
            for (int ks = 0; ks < 4; ++ks) {
                const bf16x8_t k0 = frag2(lds + KT + fr * QS + (32 * ks + 4 * g) * 2, lds + KT + fr * QS + (32 * ks + 16 + 4 * g) * 2);
                const bf16x8_t k1 = frag2(lds + KT + (16 + fr) * QS + (32 * ks + 4 * g) * 2, lds + KT + (16 + fr) * QS + (32 * ks + 16 + 4 * g) * 2);
                at0 = __builtin_amdgcn_mfma_f32_16x16x32_bf16(k0, qf[0][ks], at0, 0, 0, 0);
                at1 = __builtin_amdgcn_mfma_f32_16x16x32_bf16(k0, qf[1][ks], at1, 0, 0, 0);
                at2 = __builtin_amdgcn_mfma_f32_16x16x32_bf16(k1, qf[1][ks], at2, 0, 0, 0);
            }
#pragma unroll
            for (int r = 0; r < 4; ++r) { const bool keep = (4 * g + r) <= fr; at0[r] = keep ? at0[r] : 0.f; at2[r] = keep ? at2[r] : 0.f; }
            const f32x4 z4 = {0.f, 0.f, 0.f, 0.f};
            const bf16x8_t af0 = packf(at0, z4), af1 = packf(at1, at2);
            o0 = __builtin_amdgcn_mfma_f32_16x16x32_bf16(af0, vf, o0, 0, 0, 0);
            o1 = __builtin_amdgcn_mfma_f32_16x16x32_bf16(af1, vf, o1, 0, 0, 0);
#pragma unroll
            for (int r = 0; r < 4; ++r) { *(LAS float*)(lds + OS + (4 * g + r) * OSS + (16 * w + fr) * 4) = o0[r]; *(LAS float*)(lds + OS + (16 + 4 * g + r) * OSS + (16 * w + fr) * 4) = o1[r]; }
        }
#pragma unroll
        for (int dt = 0; dt < 8; ++dt) {
            const bf16x8_t hf = fragtr(lds + KH + (4 * g + trq) * TS + (16 * dt + 4 * trp) * 2, lds + KH + (16 + 4 * g + trq) * TS + (16 * dt + 4 * trp) * 2);
            const f32x4 dc = *(const LAS f32x4*)(lds + DEC + (16 * dt + 4 * g) * 4);
            S[dt] = __builtin_amdgcn_mfma_f32_16x16x32_bf16(hf, vf, S[dt] * dc, 0, 0, 0);
        }
        }
        __syncthreads();
        if (P2 && !(RX & 4)) {
            const f32x4 oa = *(const LAS f32x4*)(lds + OS + t * OSS + d8 * 4), ob = *(const LAS f32x4*)(lds + OS + t * OSS + (d8 + 4) * 4);
            float sq = (oa.x * oa.x + oa.y * oa.y) + (oa.z * oa.z + oa.w * oa.w) + (ob.x * ob.x + ob.y * ob.y) + (ob.z * ob.z + ob.w * ob.w);
            sq += __shfl_xor(sq, 1); sq += __shfl_xor(sq, 2); sq += __shfl_xor(sq, 4); sq += __shfl_xor(sq, 8);
            const float rstd = rsqrtf(sq * (1.0f / HD) + EPS);
            const float r0 = oa.x * rstd * ga.x * bflo(cg.x), r1 = oa.y * rstd * ga.y * bfhi(cg.x), r2 = oa.z * rstd * ga.z * bflo(cg.y), r3 = oa.w * rstd * ga.w * bfhi(cg.y);
            const float r4 = ob.x * rstd * gb.x * bflo(cg.z), r5 = ob.y * rstd * gb.y * bfhi(cg.z), r6 = ob.z * rstd * gb.z * bflo(cg.w), r7 = ob.w * rstd * gb.w * bfhi(cg.w);
            v4u wo; wo.x = pg8::cvt_pk_bf16(r0, r1); wo.y = pg8::cvt_pk_bf16(r2, r3); wo.z = pg8::cvt_pk_bf16(r4, r5); wo.w = pg8::cvt_pk_bf16(r6, r7);
            *(GAS v4u*)(O + e0 + (size_t)c * C * D) = wo;
        }
    }
    if (!P2) {
#pragma unroll
        for (int dt = 0; dt < 8; ++dt) *(GAS f32x4*)(Lst + ((((size_t)item * 8 + w) * 8 + dt) * 64 + lane) * 4) = S[dt];
        if (pt == 0) {
#pragma unroll
            for (int e = 0; e < 8; ++e) DT[(size_t)item * HD + pd8 + e] = __expf(btot[e]);
        }
    }
}
__device__ __forceinline__ void phase_final(Frame& F) {
    const int gw = blockIdx.x * NWAVES + F.wave, NGW = F.G * NWAVES;
    const unsigned short* X = (const unsigned short*)(F.ws + WS_X); const float* ss = (const float*)(F.ws + WS_SS);
    v4u nx[4]; float ns = 0.f;
    if (gw < M) {
#pragma unroll
        for (int j = 0; j < 4; ++j) nx[j] = *((const GAS v4u*)(X + (size_t)gw * D) + F.lane + 64 * j);
        ns = (F.lane < 32) ? ss[(size_t)F.lane * M + gw] : 0.f; }
    for (int m = gw; m < M; m += NGW) {
        v4u cx[4];
#pragma unroll
        for (int j = 0; j < 4; ++j) cx[j] = nx[j];
        const float cs = ns; const int mn = m + NGW;
        if (mn < M) {
#pragma unroll
            for (int j = 0; j < 4; ++j) nx[j] = *((const GAS v4u*)(X + (size_t)mn * D) + F.lane + 64 * j);
            ns = (F.lane < 32) ? ss[(size_t)F.lane * M + mn] : 0.f; }
        const float rstd = rsqrtf(wave_sum(cs) * (1.0f / D) + EPS);
        GAS f32x4* orow = (GAS f32x4*)(F.out + (size_t)m * D) + 2 * F.lane; const GAS f32x4* gr = (const GAS f32x4*)F.fgain + 2 * F.lane;
#pragma unroll
        for (int j = 0; j < 4; ++j) { const f32x2_t p0 = unph2(cx[j].x), p1 = unph2(cx[j].y), p2 = unph2(cx[j].z), p3 = unph2(cx[j].w);
            orow[128 * j] = (f32x4){p0.x, p0.y, p1.x, p1.y} * rstd * gr[128 * j]; orow[128 * j + 1] = (f32x4){p2.x, p2.y, p3.x, p3.y} * rstd * gr[128 * j + 1]; }
    }
}

__device__ __forceinline__ void swap8(bool lo, const v4u& a0, const v4u& a1, v4u& s1, v4u& s2) {
    v4u snd, rcv; snd.x = lo ? a1.x : a0.x; snd.y = lo ? a1.y : a0.y; snd.z = lo ? a1.z : a0.z; snd.w = lo ? a1.w : a0.w;
    rcv.x = (unsigned)__builtin_amdgcn_update_dpp(0, (int)snd.x, 0x128, 0xf, 0xf, false); rcv.y = (unsigned)__builtin_amdgcn_update_dpp(0, (int)snd.y, 0x128, 0xf, 0xf, false);
    rcv.z = (unsigned)__builtin_amdgcn_update_dpp(0, (int)snd.z, 0x128, 0xf, 0xf, false); rcv.w = (unsigned)__builtin_amdgcn_update_dpp(0, (int)snd.w, 0x128, 0xf, 0xf, false);
    s1.x = lo ? a0.x : rcv.x; s1.y = lo ? a0.y : rcv.y; s1.z = lo ? a0.z : rcv.z; s1.w = lo ? a0.w : rcv.w;
    s2.x = lo ? rcv.x : a1.x; s2.y = lo ? rcv.y : a1.y; s2.z = lo ? rcv.z : a1.z; s2.w = lo ? rcv.w : a1.w;
}
template <bool XF32, bool WXG = true> struct EpiResid {
    static constexpr bool PERM = true; static constexpr bool BJ32 = true;
    __device__ __forceinline__ void after_stage(int, const pg8::Unit&) const {}
    const void* xin; void* xr; bf16* xg; float* ss; const float* gate; const float* gnext;
    __device__ __forceinline__ void operator()(const pg8::f32x4 (&acc)[2][2][4][2], const pg8::Unit& u, int wr, int wc, int fr, int fq) const {
        const int b = u.pm >> 5, row0 = u.pm * 256 + wr * 64 + fr, col0 = u.pn * 256 + wc * 64 + 8 * fq;
        f32x4 gt[2][2], gn[2][2];
#pragma unroll
        for (int bj = 0; bj < 2; ++bj)
#pragma unroll
            for (int n = 0; n < 2; ++n) { gt[bj][n] = *(const GAS f32x4*)(gate + b * D + col0 + bj * 32 + 4 * n); gn[bj][n] = *(const GAS f32x4*)(gnext + b * D + col0 + bj * 32 + 4 * n); }
        const bool lo = fr < 8;
        const int srow = (fr & 7) - fr, scol = lo ? 0 : 32;
        struct Raw { v4u h[2]; f32x4 f[2][2]; };
        auto ld = [&](int s, Raw& r) { const size_t ro = (size_t)(row0 + (s >> 2) * 128 + (s & 3) * 16) * D + col0;
#pragma unroll
            for (int bj = 0; bj < 2; ++bj) { if (XF32) { r.f[bj][0] = *(const GAS f32x4*)((const float*)xin + ro + bj * 32); r.f[bj][1] = *(const GAS f32x4*)((const float*)xin + ro + bj * 32 + 4); }
                                             else r.h[bj] = *(const GAS v4u*)((const unsigned short*)xin + ro + bj * 32); } };
        Raw cur, nxt, nx2; ld(0, nxt); ld(1, nx2);
        float sqv[8];
#pragma unroll
        for (int s = 0; s < 8; ++s) {
            const int ai = s >> 2, m = s & 3;
            cur = nxt; nxt = nx2; if (s < 6) ld(s + 2, nx2);
            asm volatile("" ::: "memory");
            const int row = row0 + ai * 128 + m * 16; float sq = 0.f;
            v4u wx[2], wg[2];
#pragma unroll
            for (int bj = 0; bj < 2; ++bj) {
                f32x4 x0, x1;
                if (XF32) { x0 = cur.f[bj][0]; x1 = cur.f[bj][1]; }
                else { const v4u xb = cur.h[bj]; const f32x2_t p0 = unph2(xb.x), p1 = unph2(xb.y), p2 = unph2(xb.z), p3 = unph2(xb.w);
                    x0 = (f32x4){p0.x, p0.y, p1.x, p1.y}; x1 = (f32x4){p2.x, p2.y, p3.x, p3.y}; }
                const f32x4 v0 = x0 + gt[bj][0] * acc[ai][bj][m][0], v1 = x1 + gt[bj][1] * acc[ai][bj][m][1];
                wx[bj].x = pkh2(v0.x, v0.y); wx[bj].y = pkh2(v0.z, v0.w); wx[bj].z = pkh2(v1.x, v1.y); wx[bj].w = pkh2(v1.z, v1.w);
                sq += (v0.x * v0.x + v0.y * v0.y) + (v0.z * v0.z + v0.w * v0.w) + (v1.x * v1.x + v1.y * v1.y) + (v1.z * v1.z + v1.w * v1.w);
                if (WXG) { const f32x4 g0 = v0 * gn[bj][0], g1 = v1 * gn[bj][1];
                    wg[bj].x = pg8::cvt_pk_bf16(g0.x, g0.y); wg[bj].y = pg8::cvt_pk_bf16(g0.z, g0.w); wg[bj].z = pg8::cvt_pk_bf16(g1.x, g1.y); wg[bj].w = pg8::cvt_pk_bf16(g1.z, g1.w); }
            }
            const size_t so = (size_t)(row + srow) * D + col0 + scol;
            { v4u s1, s2; swap8(lo, wx[0], wx[1], s1, s2);
                __builtin_nontemporal_store(s1, (GAS v4u*)((unsigned short*)xr + so)); __builtin_nontemporal_store(s2, (GAS v4u*)((unsigned short*)xr + so + 8 * D)); }
            if (WXG) { v4u s1, s2; swap8(lo, wg[0], wg[1], s1, s2); *(GAS v4u*)(xg + so) = s1; *(GAS v4u*)(xg + so + 8 * D) = s2; }
            sq += __shfl_xor(sq, 16); sq += __shfl_xor(sq, 32);
            sqv[s] = sq;
        }
        if (fq == 0) {
#pragma unroll
            for (int s = 0; s < 8; ++s) ss[(size_t)(u.pn * 4 + wc) * M + row0 + (s >> 2) * 128 + (s & 3) * 16] = sqv[s];
        }
    }
};
constexpr int RS_OFF = RING_BYTES + 1024;
__device__ __forceinline__ void row_rstd_fill(LAS float* rs, const float* ss, int pm, int tid) {
    if (tid < 256) { const float* p = ss + (size_t)pm * 256 + tid; float s = 0.f;
#pragma unroll
        for (int q = 0; q < 8; ++q) s += (p[(size_t)(4 * q) * M] + p[(size_t)(4 * q + 1) * M]) + (p[(size_t)(4 * q + 2) * M] + p[(size_t)(4 * q + 3) * M]);
        rs[tid] = rsqrtf(s * (1.0f / D) + EPS); }
}
__device__ __forceinline__ void phase_row_rstd(Frame& F, const float* ss, int pm) {
    if (F.tid < 256) { const float* p = ss + (size_t)pm * 256 + F.tid; float s = 0.f;
#pragma unroll
        for (int q = 0; q < 8; ++q) s += (p[(size_t)(4 * q) * M] + p[(size_t)(4 * q + 1) * M]) + (p[(size_t)(4 * q + 2) * M] + p[(size_t)(4 * q + 3) * M]);
        ((LAS float*)(F.lds + RS_OFF))[F.tid] = rsqrtf(s * (1.0f / D) + EPS); }
    __syncthreads();
}
struct EpiSwiglu {
    static constexpr bool PERM = true; static constexpr bool BJ32 = false;
    const LAS float* rs; const float* bias; bf16* hid; const float* ssq;
    __device__ __forceinline__ void after_stage(int tid, const pg8::Unit& u) const { row_rstd_fill((LAS float*)rs, ssq, u.pm, tid); }
    __device__ __forceinline__ void operator()(const pg8::f32x4 (&acc)[2][2][4][2], const pg8::Unit& u, int wr, int wc, int fr, int fq) const {
        const int b = u.pm >> 5, row0 = u.pm * 256 + wr * 64 + fr, cin = u.pn * 256 + wc * 32 + 8 * fq, cout = u.pn * 128 + wc * 32 + 8 * fq;
        f32x4 bs[2][2];
#pragma unroll
        for (int bj = 0; bj < 2; ++bj)
#pragma unroll
            for (int n = 0; n < 2; ++n) bs[bj][n] = *(const GAS f32x4*)(bias + (size_t)b * NFF2 + cin + bj * 128 + 4 * n);
#pragma unroll
        for (int ai = 0; ai < 2; ++ai)
#pragma unroll
            for (int m = 0; m < 4; ++m) {
                const int row = row0 + ai * 128 + m * 16; const float rstd = rs[ai * 128 + wr * 64 + m * 16 + fr];
                float hv[8];
#pragma unroll
                for (int n = 0; n < 2; ++n) { const f32x4 a = acc[ai][0][m][n] * rstd + bs[0][n], bb = acc[ai][1][m][n] * rstd + bs[1][n];
#pragma unroll
                    for (int e = 0; e < 4; ++e) hv[4 * n + e] = a[e] * sigmoidf_(a[e]) * bb[e]; }
                v4u w; w.x = pg8::cvt_pk_bf16(hv[0], hv[1]); w.y = pg8::cvt_pk_bf16(hv[2], hv[3]); w.z = pg8::cvt_pk_bf16(hv[4], hv[5]); w.w = pg8::cvt_pk_bf16(hv[6], hv[7]);
                *(GAS v4u*)(hid + (size_t)row * DFF + cout) = w;
            }
    }
};
struct EpiProj {
    static constexpr bool PERM = true; static constexpr bool BJ32 = true;
    const LAS float* rs; const float* bias; const float* lb; bf16* out; const float* ssq;
    __device__ __forceinline__ void after_stage(int tid, const pg8::Unit& u) const { row_rstd_fill((LAS float*)rs, ssq, u.pm, tid); }
    template <int TYP> __device__ __forceinline__ void body(const pg8::f32x4 (&acc)[2][2][4][2], const pg8::Unit& u, int wr, int wc, int fr, int fq) const {
        const int b = u.pm >> 5, row0 = u.pm * 256 + wr * 64 + fr, cin = u.pn * 256 + wc * 64 + 8 * fq, cout = (u.pn & 7) * 256 + wc * 64 + 8 * fq;
        bf16* dst = out + (size_t)TYP * M * D;
        const bool lo = fr < 8; const int srow = (fr & 7) - fr, scol = lo ? 0 : 32;
        f32x4 bs[2][2], lbv[2][2];
#pragma unroll
        for (int bj = 0; bj < 2; ++bj)
#pragma unroll
            for (int n = 0; n < 2; ++n) { bs[bj][n] = *(const GAS f32x4*)(bias + (size_t)b * NPROJ + cin + bj * 32 + 4 * n); lbv[bj][n] = (TYP == 1) ? *(const GAS f32x4*)(lb + cout + bj * 32 + 4 * n) : (f32x4){0.f, 0.f, 0.f, 0.f}; }
#pragma unroll
        for (int ai = 0; ai < 2; ++ai)
#pragma unroll
            for (int m = 0; m < 4; ++m) {
                const int row = row0 + ai * 128 + m * 16; const float rstd = rs[ai * 128 + wr * 64 + m * 16 + fr];
                v4u wq[2];
#pragma unroll
                for (int bj = 0; bj < 2; ++bj) {
                    float r[8];
#pragma unroll
                    for (int n = 0; n < 2; ++n) { const f32x4 v = acc[ai][bj][m][n] * rstd + bs[bj][n];
#pragma unroll
                        for (int e = 0; e < 4; ++e) { float x = v[e];
                            if (TYP == 1) { const float lo = lbv[bj][n][e]; x = __logf(lo + (1.0f - lo) * sigmoidf_(x)); }
                            if (TYP == 3) x = x * sigmoidf_(x);
                            r[4 * n + e] = x; } }
                    wq[bj].x = pg8::cvt_pk_bf16(r[0], r[1]); wq[bj].y = pg8::cvt_pk_bf16(r[2], r[3]); wq[bj].z = pg8::cvt_pk_bf16(r[4], r[5]); wq[bj].w = pg8::cvt_pk_bf16(r[6], r[7]);
                }
                { v4u s1, s2; swap8(lo, wq[0], wq[1], s1, s2); const size_t so = (size_t)(row + srow) * D + cout + scol; *(GAS v4u*)(dst + so) = s1; *(GAS v4u*)(dst + so + 8 * D) = s2; }
            }
    }
    __device__ __forceinline__ void operator()(const pg8::f32x4 (&acc)[2][2][4][2], const pg8::Unit& u, int wr, int wc, int fr, int fq) const {
        const int typ = u.pn >> 3;
        if (typ == 1) body<1>(acc, u, wr, wc, fr, fq); else if (typ == 3) body<3>(acc, u, wr, wc, fr, fq); else if (typ == 0) body<0>(acc, u, wr, wc, fr, fq); else body<2>(acc, u, wr, wc, fr, fq);
    }
};
struct EpiNull {
    static constexpr bool PERM = true; static constexpr bool BJ32 = false;
    float* dummy;
    __device__ __forceinline__ void after_stage(int, const pg8::Unit&) const {}
    __device__ __forceinline__ void operator()(const pg8::f32x4 (&acc)[2][2][4][2], const pg8::Unit& u, int wr, int wc, int fr, int fq) const {
        f32x4 s = {0.f, 0.f, 0.f, 0.f};
#pragma unroll
        for (int ai = 0; ai < 2; ++ai)
#pragma unroll
            for (int bj = 0; bj < 2; ++bj)
#pragma unroll
                for (int m = 0; m < 4; ++m)
#pragma unroll
                    for (int n = 0; n < 2; ++n) s += acc[ai][bj][m][n];
        if (s.x + s.y + s.z + s.w == 12345.678f) dummy[(u.pm * 64 + u.pn) * 512 + threadIdx.x] = s.x;
    }
};
#ifndef MK_RX
#define MK_RX 0
#endif
#ifndef MK_XP
#define MK_XP 0
#endif
#ifndef MK_REPEAT_NULL
#define MK_REPEAT_NULL 0
#endif
#ifndef MK_REPEAT
#define MK_REPEAT -1
#endif
#ifndef MK_REPEAT_N
#define MK_REPEAT_N 1
#endif
#ifndef MK_NAIVE_REC
#define MK_NAIVE_REC 0
#endif
#ifndef MK_SP2
#define MK_SP2 true
#endif
#ifndef MK_ALIGN
#define MK_ALIGN true
#endif

struct Args { const float* in[15]; float* out; unsigned char* ws; int ph_lo, ph_hi; };
struct RowSplitOrder : pg8::StaticOrder {
    __device__ bool next(int i, pg8::Unit& u) const {
        if (G != 256 || nM != 64 || nN != 8) return pg8::StaticOrder::next(i, u);
        if (i >= 2) return false;
        const int x = c & 7, off = c >> 3; u.pm = 8 * x + 4 * i + (off & 3); u.pn = off >> 2; return true;
    }
};
template <int l> __device__ __forceinline__ void layer_phases(Frame& F, const Args& args, const XcdBarrier& bar, int lo, int hi) {
#define IN(k) (lo <= (k) && (k) < hi)
#define SEAM(k) do { if (IN(k) && IN((k) + 1)) xcd_barrier(bar, F.wave); } while (0)
#define RUNPH(k, ...) do { if (IN(k)) { F.lane = lane_id(); F.tid = F.wave * 64 + F.lane; if (MK_REPEAT == (k)) { _Pragma("unroll") for (int _r = 0; _r < MK_REPEAT_N; ++_r) { { __VA_ARGS__ } xcd_barrier(bar, F.wave); } } { __VA_ARGS__ } } } while (0)
    unsigned short* X = (unsigned short*)(args.ws + WS_X); bf16* XG = (bf16*)(args.ws + WS_XG); bf16* AOP = (bf16*)(args.ws + WS_AOP); bf16* HID = (bf16*)(args.ws + WS_HID); bf16* PROJ = (bf16*)(args.ws + WS_PROJ);
    float* SS = (float*)(args.ws + WS_SS);
    unsigned short* DX = (unsigned short*)(args.ws + WS_END); bf16* DXG = (bf16*)(args.ws + WS_END + 128 * MiB); float* DSS = (float*)(args.ws + WS_END + 192 * MiB);
    int rep_i = 0; (void)rep_i; (void)DX; (void)DXG; (void)DSS;
    constexpr int pb = 3 + (l >> 1) * 10 + (l & 1) * 4, j = l >> 1;
    constexpr bool pool = (l & 1) == 0;
    constexpr int pf = pool ? pb + 2 : pb + 4;
    const void* xsrc = (l == 0) ? (const void*)F.x : (const void*)X;
    if constexpr (pool) {
        if constexpr (l != 0) { RUNPH(pb, phase_poolprep<false>(F, l, xsrc);); SEAM(pb); }
    } else {
        RUNPH(pb,
            pg8::Gemm g{XG, (const bf16*)(args.ws + WS_WHIN) + (size_t)j * NPROJ * D, D, D, D, 0}; pg8::StaticOrder S; S.init(M, NPROJ, F.G, (int)blockIdx.x);
            EpiProj E{(const LAS float*)(F.lds + RS_OFF), F.vec + V_BIASP + (size_t)j * 2 * NPROJ, F.vec + V_LB + j * D, PROJ, SS};
            pg8::gemm_phase<EpiProj, pg8::StaticOrder, MK_ALIGN, MK_SP2>(F.lds + RING_OFF, g, S, E, F.wave);
        ); SEAM(pb);
        RUNPH(pb + 1, phase_rec<false>(F, j);); SEAM(pb + 1);
        RUNPH(pb + 2, if (MK_RX != 0 && MK_REPEAT == pb + 2 && rep_i++ < MK_REPEAT_N) phase_rec<true, MK_RX>(F, j); else phase_rec<true>(F, j);); SEAM(pb + 2);
    }
    RUNPH(pf - 1,
        const bool dmy = (MK_REPEAT == pf - 1) && (rep_i++ < MK_REPEAT_N);
        pg8::Gemm g{AOP, pool ? (const bf16*)(args.ws + WS_WPOOL) + (size_t)j * 4 * PGD * PGD : (const bf16*)(args.ws + WS_WHOUT) + (size_t)j * D * D, D, pool ? PGD : D, pool ? PGD : D, pool ? PGD * 2 : 0};
        RowSplitOrder S; S.init(M, D, F.G, (int)blockIdx.x);
        EpiResid<l == 0> E{xsrc, dmy ? DX : X, dmy ? DXG : XG, dmy ? DSS : SS, F.vec + V_GATEM + l * 2 * D, F.vec + V_GF + l * 2 * D};
        pg8::gemm_phase<EpiResid<l == 0>, RowSplitOrder, MK_ALIGN, MK_SP2>(F.lds + RING_OFF, g, S, E, F.wave);
    ); SEAM(pf - 1);
    RUNPH(pf,
        pg8::Gemm g{XG, (const bf16*)(args.ws + WS_WFIN) + (size_t)l * NFF2 * D, D, D, D, 0}; pg8::StaticOrder S; S.init(M, NFF2, F.G, (int)blockIdx.x);
        if (MK_REPEAT_NULL && MK_REPEAT == pf && rep_i++ < MK_REPEAT_N) { EpiNull E0{DSS}; pg8::gemm_phase<EpiNull, pg8::StaticOrder, MK_ALIGN, MK_SP2, MK_XP>(F.lds + RING_OFF, g, S, E0, F.wave); }
        else {
        EpiSwiglu E{(const LAS float*)(F.lds + RS_OFF), F.vec + V_BIASF + (size_t)l * 2 * NFF2, HID, SS};
        pg8::gemm_phase<EpiSwiglu, pg8::StaticOrder, MK_ALIGN, MK_SP2>(F.lds + RING_OFF, g, S, E, F.wave); }
    ); SEAM(pf);
    RUNPH(pf + 1,
        const bool dmy = (MK_REPEAT == pf + 1) && (rep_i++ < MK_REPEAT_N);
        pg8::Gemm g{HID, (const bf16*)(args.ws + WS_WFOUT) + (size_t)l * D * DFF, DFF, DFF, DFF, 0}; RowSplitOrder S; S.init(M, D, F.G, (int)blockIdx.x);
        EpiResid<false, pool> E{X, dmy ? DX : X, dmy ? DXG : XG, dmy ? DSS : SS, F.vec + V_GATEF + l * 2 * D, F.vec + V_GM + ((l + 1) & 3) * 2 * D};
        pg8::gemm_phase<EpiResid<false, pool>, RowSplitOrder, MK_ALIGN, MK_SP2>(F.lds + RING_OFF, g, S, E, F.wave);
    ); SEAM(pf + 1);
#undef RUNPH
#undef IN
#undef SEAM
}
__global__ void __launch_bounds__(NWAVES * 64, 2) mk_fwd(Args args) {
    extern __shared__ __attribute__((aligned(16))) unsigned char lds[];
    Frame F;
    F.lds = (LAS unsigned char*)lds;
    F.tid = threadIdx.x; F.lane = F.tid & 63; F.wave = __builtin_amdgcn_readfirstlane(F.tid >> 6); F.G = gridDim.x;
    F.x = args.in[0]; F.c = args.in[1]; F.gmix = args.in[2]; F.gffn = args.in[3]; F.wada = args.in[4]; F.bada = args.in[5]; F.poolw = args.in[6]; F.pools = args.in[7];
    F.hwin = args.in[8]; F.hwout = args.in[9]; F.hgain = args.in[10]; F.hlb = args.in[11]; F.wfin = args.in[12]; F.wfout = args.in[13]; F.fgain = args.in[14];
    F.out = args.out; F.ws = args.ws; F.vec = (float*)(args.ws + WS_VEC);
    volatile LAS unsigned* MISC = (volatile LAS unsigned*)(F.lds + MISC_OFF);
    for (int u = F.tid; u < (LDS_BYTES - LDSCTL_OFF) / 4; u += NWAVES * 64) ((LAS unsigned*)(F.lds + LDSCTL_OFF))[u] = 0u;
    __syncthreads();
    const int lo = args.ph_lo, hi = args.ph_hi;
    const bool multi = (hi - lo) > 1;
    XcdBarrier bar; bar.bar = (unsigned*)(args.ws + WS_CTL) + CW_BAR; bar.x = 0; bar.st = nullptr;
    if (multi) bar = xcd_barrier_post((unsigned*)(args.ws + WS_CTL) + CW_BAR, MISC + 8);
#define IN(k) (lo <= (k) && (k) < hi)
#define SEAM(k) do { if (IN(k) && IN((k) + 1)) xcd_barrier(bar, F.wave); } while (0)

#define RUNPH(k, ...) do { if (IN(k)) { F.lane = lane_id(); F.tid = F.wave * 64 + F.lane; if (MK_REPEAT == (k)) { _Pragma("unroll") for (int _r = 0; _r < MK_REPEAT_N; ++_r) { { __VA_ARGS__ } xcd_barrier(bar, F.wave); } } { __VA_ARGS__ } } } while (0)
    RUNPH(0, phase_p0a(F);); SEAM(0);
    RUNPH(1, phase_p0b(F);); SEAM(1);
    RUNPH(2, phase_p0c(F); __syncthreads(); phase_poolprep<true>(F, 0, (const void*)F.x);); SEAM(2);

    layer_phases<0>(F, args, bar, lo, hi); layer_phases<1>(F, args, bar, lo, hi); layer_phases<2>(F, args, bar, lo, hi); layer_phases<3>(F, args, bar, lo, hi);
    RUNPH(NPHASE - 1, phase_final(F););
#undef RUNPH
#undef IN
#undef SEAM
}

#ifndef MK_N_LAUNCHES
#define MK_N_LAUNCHES 1
#endif
extern "C" void kernel_launch(void* const* d_in, const int* in_sizes, int n_in, void* d_out, int out_size, void* d_ws, size_t ws_size, hipStream_t stream) {
    static int grid = 0;
    if (grid == 0) {
        if (n_in != 15 || in_sizes[0] != M * D || out_size != M * D || ws_size < WS_END) { fprintf(stderr, "kernel_launch: unexpected shapes (n_in %d in0 %d out %d ws %zu)\n", n_in, n_in > 0 ? in_sizes[0] : -1, out_size, ws_size); grid = -1; return; }
        int dev = 0, cus = 0, per_cu = 0;
        if (hipGetDevice(&dev) != hipSuccess || hipDeviceGetAttribute(&cus, hipDeviceAttributeMultiprocessorCount, dev) != hipSuccess) { grid = -1; return; }
        if (hipFuncSetAttribute((const void*)mk_fwd, hipFuncAttributeMaxDynamicSharedMemorySize, LDS_BYTES) != hipSuccess) { fprintf(stderr, "kernel_launch: hipFuncSetAttribute failed\n"); grid = -1; return; }
        if (hipOccupancyMaxActiveBlocksPerMultiprocessor(&per_cu, (const void*)mk_fwd, NWAVES * 64, LDS_BYTES) != hipSuccess || per_cu < 1) fprintf(stderr, "kernel_launch: occupancy query says %d\n", per_cu);
        (void)hipGetLastError();
        grid = cus;
    }
    if (grid < 0) return;
    if (hipMemsetAsync((char*)d_ws + WS_CTL, 0, CTL_ZERO_BYTES, stream) != hipSuccess) return;
    Args a{};
    for (int i = 0; i < 15; ++i) a.in[i] = (const float*)d_in[i];
    a.out = (float*)d_out; a.ws = (unsigned char*)d_ws;
    if (MK_N_LAUNCHES == 1) { a.ph_lo = 0; a.ph_hi = NPHASE; hipLaunchKernelGGL(mk_fwd, dim3(grid), dim3(NWAVES * 64), LDS_BYTES, stream, a); }
    else for (int p = 0; p < NPHASE; ++p) { a.ph_lo = p; a.ph_hi = p + 1; hipLaunchKernelGGL(mk_fwd, dim3(grid), dim3(NWAVES * 64), LDS_BYTES, stream, a); }
}
```
